# Optimizing an MI355X kernel written in HIP

```python
import jax, jax.numpy as jnp
from jax import lax
import numpy as np

D_MODEL = 2048
BATCH = 2
SEQ = 4096
DEPTH = 1

CHUNK = 64
HEAD_DIM = 128
N_HEADS_A = 8
N_HEADS_B = 8
WIDTH_A = N_HEADS_A * HEAD_DIM
WIDTH_B = N_HEADS_B * HEAD_DIM
MIX_WIDTH = WIDTH_A + WIDTH_B
LEFT_CHUNKS = 8
BAND = (LEFT_CHUNKS + 1) * CHUNK
MAX_REL = 128
IDX_HEADS = 16
IDX_DIM = 64
TOPK_MAX = 256
Q_BLOCK = 128
ROPE_THETA = 500000.0
ROPE_FRACTION = 4
PEER_HEADS = 8
PEER_KEYS = 128
PEER_EXPERTS = PEER_KEYS * PEER_KEYS
PEER_QDIM = 256
PEER_TOPK = 16
PEER_BLOCK = 128
PLE_DIM = 256
IN_PROJ_WIDTH = 3 * WIDTH_A + 3 * WIDTH_B + IDX_HEADS * IDX_DIM + IDX_DIM + IDX_HEADS
EPS = 1e-6

kernel_name = "hybrid_chunk_relpos_dsa_peer_block"


def rms_norm(x, g):
    xf = x.astype(jnp.float32)
    y = xf * lax.rsqrt(jnp.mean(xf * xf, axis=-1, keepdims=True) + EPS)
    return (y * g.astype(jnp.float32)).astype(x.dtype)


def partial_rope(x, pos):
    rot = x.shape[-1] // ROPE_FRACTION
    half = rot // 2
    inv_freq = 1.0 / (ROPE_THETA ** (jnp.arange(half, dtype=jnp.float32) / half))
    ang = pos.astype(jnp.float32)[..., None] * inv_freq
    cos = jnp.cos(ang)[:, :, None, :]
    sin = jnp.sin(ang)[:, :, None, :]
    x1 = x[..., :half].astype(jnp.float32)
    x2 = x[..., half:rot].astype(jnp.float32)
    r1 = (x1 * cos - x2 * sin).astype(x.dtype)
    r2 = (x2 * cos + x1 * sin).astype(x.dtype)
    return jnp.concatenate([r1, r2, x[..., rot:]], axis=-1)


def split_offsets():
    sizes = (WIDTH_A, WIDTH_A, WIDTH_A, WIDTH_B, WIDTH_B, WIDTH_B,
             IDX_HEADS * IDX_DIM, IDX_DIM, IDX_HEADS)
    offs = []
    acc = 0
    for s in sizes[:-1]:
        acc += s
        offs.append(acc)
    return offs


def chunked_relpos_attention(q, k, v, rel_bias):
    B, S, H, d = q.shape
    nc = S // CHUNK
    qc = q.reshape(B, nc, CHUNK, H, d)
    pad = ((0, 0), (LEFT_CHUNKS * CHUNK, 0), (0, 0), (0, 0))
    kp = jnp.pad(k, pad).reshape(B, nc + LEFT_CHUNKS, CHUNK, H, d)
    vp = jnp.pad(v, pad).reshape(B, nc + LEFT_CHUNKS, CHUNK, H, d)
    band_idx = jnp.arange(nc)[:, None] + jnp.arange(LEFT_CHUNKS + 1)[None, :]
    kb = kp[:, band_idx].reshape(B, nc, BAND, H, d)
    vb = vp[:, band_idx].reshape(B, nc, BAND, H, d)
    s = jnp.einsum('bcqhd,bckhd->bhcqk', qc, kb, preferred_element_type=jnp.float32) * (d ** -0.5)
    dist = jnp.arange(CHUNK)[:, None] + LEFT_CHUNKS * CHUNK - jnp.arange(BAND)[None, :]
    dist = jnp.clip(dist, -MAX_REL, MAX_REL) + MAX_REL
    bias = rel_bias[:, dist].astype(jnp.float32)
    key_chunk = jnp.arange(nc)[:, None] - LEFT_CHUNKS + jnp.arange(LEFT_CHUNKS + 1)[None, :]
    valid = jnp.repeat(key_chunk >= 0, CHUNK, axis=1)
    s = s + bias[None, :, None]
    s = jnp.where(valid[None, None, :, None, :], s, -jnp.inf)
    pr = jax.nn.softmax(s, axis=-1)
    o = jnp.einsum('bhcqk,bckhd->bcqhd', pr.astype(vb.dtype), vb)
    return o.reshape(B, S, H * d)


def dsa_attention(q, k, v, q_idx, k_idx, w_idx):
    B, S, H, d = q.shape
    topk = min(TOPK_MAX, S // 4)
    nb = S // Q_BLOCK
    key_chunk = jnp.arange(S) // CHUNK

    def to_blocks(a):
        return a.reshape((B, nb, Q_BLOCK) + a.shape[2:]).swapaxes(0, 1)

    def block_fn(args):
        qb, qib, wb, start = args
        q_chunk = (start + jnp.arange(Q_BLOCK)) // CHUNK
        logits = jnp.einsum('bqhi,bsi->bqhs', qib, k_idx,
                            preferred_element_type=jnp.float32) * (IDX_DIM ** -0.5)
        score = jnp.einsum('bqh,bqhs->bqs', wb.astype(jnp.float32) * (IDX_HEADS ** -0.5),
                           jax.nn.relu(logits))
        admissible = key_chunk[None, :] <= q_chunk[:, None]
        score = jnp.where(admissible[None], score, -jnp.inf)
        _, sel = lax.top_k(score, topk)
        sel_ok = key_chunk[sel] <= q_chunk[None, :, None]
        ks = jax.vmap(lambda kk, ii: kk[ii])(k, sel)
        vs = jax.vmap(lambda vv, ii: vv[ii])(v, sel)
        att = jnp.einsum('bqhd,bqkhd->bqhk', qb, ks, preferred_element_type=jnp.float32) * (d ** -0.5)
        att = jnp.where(sel_ok[:, :, None, :], att, -jnp.inf)
        pr = jax.nn.softmax(att, axis=-1)
        return jnp.einsum('bqhk,bqkhd->bqhd', pr.astype(vs.dtype), vs)

    starts = jnp.arange(nb, dtype=jnp.int32) * Q_BLOCK
    out = lax.map(block_fn, (to_blocks(q), to_blocks(q_idx), to_blocks(w_idx), starts))
    return out.swapaxes(0, 1).reshape(B, S, H * d)


def peer_ffn(x, w_query, sub_keys, expert_u, expert_v):
    B, S, D = x.shape
    nb = S // PEER_BLOCK
    half = PEER_QDIM // 2
    xb = x.reshape(B, nb, PEER_BLOCK, D).swapaxes(0, 1)

    def block_fn(xt):
        qv = (xt @ w_query).reshape(B, PEER_BLOCK, PEER_HEADS, 2, half)
        s1 = jnp.einsum('bthd,nd->bthn', qv[..., 0, :], sub_keys[0], preferred_element_type=jnp.float32)
        s2 = jnp.einsum('bthd,nd->bthn', qv[..., 1, :], sub_keys[1], preferred_element_type=jnp.float32)
        v1, i1 = lax.top_k(s1, PEER_TOPK)
        v2, i2 = lax.top_k(s2, PEER_TOPK)
        cand = (v1[..., :, None] + v2[..., None, :]).reshape(B, PEER_BLOCK, PEER_HEADS, PEER_TOPK * PEER_TOPK)
        sc, ci = lax.top_k(cand, PEER_TOPK)
        e1 = jnp.take_along_axis(i1, ci // PEER_TOPK, axis=-1)
        e2 = jnp.take_along_axis(i2, ci % PEER_TOPK, axis=-1)
        expert = e1 * PEER_KEYS + e2
        g = jax.nn.softmax(sc, axis=-1)
        u_sel = expert_u[expert]
        v_sel = expert_v[expert]
        act = jax.nn.gelu(jnp.einsum('btd,bthkd->bthk', xt, u_sel, preferred_element_type=jnp.float32))
        coef = (g * act).astype(xt.dtype)
        return jnp.einsum('bthk,bthkd->btd', coef, v_sel)

    out = lax.map(block_fn, xb)
    return out.swapaxes(0, 1).reshape(B, S, D)


def setup_inputs(seed: int = 0) -> dict:
    key = jax.random.key(seed)
    ks = jax.random.split(key, 20)
    f32 = jnp.float32

    def nrm(k, shape, scale):
        return jax.random.normal(k, shape, f32) * scale

    def gain(k, shape):
        return 1.0 + 0.01 * jax.random.normal(k, shape, f32)

    x = jax.random.normal(ks[0], (BATCH, SEQ, D_MODEL), f32)
    p = jax.random.normal(ks[1], (DEPTH, BATCH, SEQ, PLE_DIM), f32)
    offset = jax.random.randint(ks[2], (BATCH, 1), 0, 1024, dtype=jnp.int32)
    positions = offset + jnp.arange(SEQ, dtype=jnp.int32)[None, :]
    return {
        "x": x,
        "p": p,
        "positions": positions,
        "norm_mix": gain(ks[3], (DEPTH, D_MODEL)),
        "w_in": nrm(ks[4], (DEPTH, D_MODEL, IN_PROJ_WIDTH), D_MODEL ** -0.5),
        "qk_norm_a": gain(ks[5], (DEPTH, 2, HEAD_DIM)),
        "qk_norm_b": gain(ks[6], (DEPTH, 2, HEAD_DIM)),
        "rel_bias": nrm(ks[7], (DEPTH, N_HEADS_A, 2 * MAX_REL + 1), 0.1),
        "w_out": nrm(ks[8], (DEPTH, MIX_WIDTH, D_MODEL), MIX_WIDTH ** -0.5),
        "norm_ffn": gain(ks[9], (DEPTH, D_MODEL)),
        "peer_query": nrm(ks[10], (DEPTH, D_MODEL, PEER_HEADS * PEER_QDIM), D_MODEL ** -0.5),
        "peer_sub_keys": nrm(ks[11], (DEPTH, 2, PEER_KEYS, PEER_QDIM // 2), (PEER_QDIM // 2) ** -0.5),
        "peer_u": nrm(ks[12], (DEPTH, PEER_EXPERTS, D_MODEL), D_MODEL ** -0.5),
        "peer_v": nrm(ks[13], (DEPTH, PEER_EXPERTS, D_MODEL), PEER_HEADS ** -0.5),
        "norm_ple": gain(ks[14], (DEPTH, D_MODEL)),
        "ple_gate": nrm(ks[15], (DEPTH, D_MODEL, D_MODEL), D_MODEL ** -0.5),
        "ple_proj": nrm(ks[16], (DEPTH, PLE_DIM, D_MODEL), PLE_DIM ** -0.5),
    }


def reference(x, p, positions, norm_mix, w_in, qk_norm_a, qk_norm_b, rel_bias, w_out,
              norm_ffn, peer_query, peer_sub_keys, peer_u, peer_v, norm_ple, ple_gate, ple_proj):
    B, S, _ = x.shape
    offs = split_offsets()
    h = x
    for i in range(DEPTH):
        hn = rms_norm(h, norm_mix[i])
        proj = hn @ w_in[i]
        qa, ka, va, qb, kb, vb, qi, ki, wi = jnp.split(proj, offs, axis=-1)
        qa = rms_norm(qa.reshape(B, S, N_HEADS_A, HEAD_DIM), qk_norm_a[i, 0])
        ka = rms_norm(ka.reshape(B, S, N_HEADS_A, HEAD_DIM), qk_norm_a[i, 1])
        va = va.reshape(B, S, N_HEADS_A, HEAD_DIM)
        out_a = chunked_relpos_attention(qa, ka, va, rel_bias[i])
        qb = partial_rope(rms_norm(qb.reshape(B, S, N_HEADS_B, HEAD_DIM), qk_norm_b[i, 0]), positions)
        kb = partial_rope(rms_norm(kb.reshape(B, S, N_HEADS_B, HEAD_DIM), qk_norm_b[i, 1]), positions)
        vb = vb.reshape(B, S, N_HEADS_B, HEAD_DIM)
        qi = partial_rope(qi.reshape(B, S, IDX_HEADS, IDX_DIM), positions)
        ki = partial_rope(ki[:, :, None, :], positions)[:, :, 0, :]
        out_b = dsa_attention(qb, kb, vb, qi, ki, wi)
        h = h + jnp.concatenate([out_a, out_b], axis=-1) @ w_out[i]
        h = h + peer_ffn(rms_norm(h, norm_ffn[i]), peer_query[i], peer_sub_keys[i], peer_u[i], peer_v[i])
        gate = jax.nn.sigmoid(rms_norm(h, norm_ple[i]) @ ple_gate[i])
        h = h + gate * (p[i] @ ple_proj[i])
    return h
```

```cpp
#include <hip/hip_runtime.h>
#include <cstdio>
#include <cstdint>
#include <cmath>

namespace cfg {
constexpr int B = 2, S = 4096, T = B * S, D = 2048, CH = 64, HD = 128, NHA = 8, NHB = 8, LEFT = 8, BAND = 576, MAXREL = 128;
constexpr int IH = 16, ID = 64, TOPK = 256, PH = 8, PK = 128, PQD = 256, PTOP = 16, PLE = 256, NPROJ = 7248;
constexpr int OFF_QA = 0, OFF_KA = 1024, OFF_VA = 2048, OFF_QB = 3072, OFF_KB = 4096, OFF_VB = 5120, OFF_QI = 6144, OFF_KI = 7168, OFF_WI = 7232;
constexpr float EPS = 1e-6f;
}
namespace nv {
using namespace cfg;
#ifndef NAIVE_RB
#define NAIVE_RB 0
#endif

__device__ __forceinline__ float wsum(float v) {
#pragma unroll
    for (int o = 32; o > 0; o >>= 1) v += __shfl_xor(v, o);
    return v;
}
__device__ __forceinline__ float wmax(float v) {
#pragma unroll
    for (int o = 32; o > 0; o >>= 1) v = fmaxf(v, __shfl_xor(v, o));
    return v;
}
__device__ __forceinline__ int wsumi(int v) {
#pragma unroll
    for (int o = 32; o > 0; o >>= 1) v += __shfl_xor(v, o);
    return v;
}
__device__ __forceinline__ unsigned skey(float f) {
    unsigned u = __float_as_uint(f);
    return (u & 0x80000000u) ? ~u : (u | 0x80000000u);
}

__device__ __forceinline__ float rbf(float f) { unsigned u = __float_as_uint(f); u = (u + 0x7fffu + ((u >> 16) & 1u)) & 0xffff0000u; return __uint_as_float(u); }
__global__ __launch_bounds__(256) void k_rmsnorm(const float* __restrict__ x, const float* __restrict__ g, float* __restrict__ y) {
    __shared__ float red[4];
    const int row = blockIdx.x, tid = threadIdx.x;
    const float4* xr = (const float4*)(x + (size_t)row * D);
    float4 a = xr[tid], b = xr[tid + 256];
    float s = a.x * a.x + a.y * a.y + a.z * a.z + a.w * a.w + b.x * b.x + b.y * b.y + b.z * b.z + b.w * b.w;
    s = wsum(s);
    if ((tid & 63) == 0) red[tid >> 6] = s;
    __syncthreads();
    const float tot = red[0] + red[1] + red[2] + red[3];
    const float sc = rsqrtf(tot * (1.0f / D) + EPS);
    const float4 ga = ((const float4*)g)[tid], gb = ((const float4*)g)[tid + 256];
    float4* yr = (float4*)(y + (size_t)row * D);
    yr[tid] = make_float4(a.x * sc * ga.x, a.y * sc * ga.y, a.z * sc * ga.z, a.w * sc * ga.w);
    yr[tid + 256] = make_float4(b.x * sc * gb.x, b.y * sc * gb.y, b.z * sc * gb.z, b.w * sc * gb.w);
}

template <bool ADD, bool RB = false>
__global__ __launch_bounds__(256) void k_sgemm(const float* __restrict__ A, const float* __restrict__ Bm, float* __restrict__ C,
                                               const float* __restrict__ R, int M, int N, int K) {
    __shared__ float As[8][132];
    __shared__ float Bs[8][132];
    const int tid = threadIdx.x, tx = tid & 15, ty = tid >> 4;
    const int m0 = blockIdx.y * 128, n0 = blockIdx.x * 128;
    float acc[8][8];
#pragma unroll
    for (int i = 0; i < 8; ++i)
#pragma unroll
        for (int j = 0; j < 8; ++j) acc[i][j] = 0.f;
    const int a_row = tid >> 1, a_k = (tid & 1) * 4;
    const int b_k = tid >> 5, b_n = (tid & 31) * 4;
    for (int k0 = 0; k0 < K; k0 += 8) {
        float4 av = *(const float4*)(A + (size_t)(m0 + a_row) * K + k0 + a_k);
        float4 bv = make_float4(0.f, 0.f, 0.f, 0.f);
        if (n0 + b_n < N) bv = *(const float4*)(Bm + (size_t)(k0 + b_k) * N + n0 + b_n);
        if (RB) { av.x = rbf(av.x); av.y = rbf(av.y); av.z = rbf(av.z); av.w = rbf(av.w); bv.x = rbf(bv.x); bv.y = rbf(bv.y); bv.z = rbf(bv.z); bv.w = rbf(bv.w); }
        __syncthreads();
        As[a_k + 0][a_row] = av.x; As[a_k + 1][a_row] = av.y; As[a_k + 2][a_row] = av.z; As[a_k + 3][a_row] = av.w;
        *(float4*)&Bs[b_k][b_n] = bv;
        __syncthreads();
#pragma unroll
        for (int kk = 0; kk < 8; ++kk) {
            const float4 a0 = *(const float4*)&As[kk][ty * 8], a1 = *(const float4*)&As[kk][ty * 8 + 4];
            const float4 b0 = *(const float4*)&Bs[kk][tx * 8], b1 = *(const float4*)&Bs[kk][tx * 8 + 4];
            const float a[8] = {a0.x, a0.y, a0.z, a0.w, a1.x, a1.y, a1.z, a1.w};
            const float b[8] = {b0.x, b0.y, b0.z, b0.w, b1.x, b1.y, b1.z, b1.w};
#pragma unroll
            for (int i = 0; i < 8; ++i)
#pragma unroll
                for (int j = 0; j < 8; ++j) acc[i][j] = fmaf(a[i], b[j], acc[i][j]);
        }
    }
#pragma unroll
    for (int i = 0; i < 8; ++i) {
        const size_t ro = (size_t)(m0 + ty * 8 + i) * N;
#pragma unroll
        for (int jj = 0; jj < 2; ++jj) {
            const int col = n0 + tx * 8 + jj * 4;
            if (col < N) {
                float4 v = make_float4(acc[i][jj * 4 + 0], acc[i][jj * 4 + 1], acc[i][jj * 4 + 2], acc[i][jj * 4 + 3]);
                if (ADD) { const float4 r = *(const float4*)(R + ro + col); v.x += r.x; v.y += r.y; v.z += r.z; v.w += r.w; }
                *(float4*)(C + ro + col) = v;
            }
        }
    }
}

template <bool RB>
__global__ __launch_bounds__(256) void k_postproj(float* __restrict__ proj, const int* __restrict__ positions,
                                                  const float* __restrict__ gqa  , const float* __restrict__ gqb  ) {
    const int t = blockIdx.x, tid = threadIdx.x, wave = tid >> 6, lane = tid & 63;
    float* row = proj + (size_t)t * NPROJ;
    const double pos = (double)positions[t];
    for (int u = wave; u < 48; u += 4) {
        const int grp = u >> 3;
        if (grp == 2 || grp == 5) { if (RB) { float* hp = row + u * 128; hp[lane] = rbf(hp[lane]); hp[lane + 64] = rbf(hp[lane + 64]); } continue; }
        float* hp = row + u * 128;
        float v0 = hp[lane], v1 = hp[lane + 64];
        const float ssq = wsum(v0 * v0 + v1 * v1);
        const float sc = rsqrtf(ssq * (1.0f / 128.f) + EPS);
        const float* g = (grp == 0) ? gqa : (grp == 1) ? gqa + 128 : (grp == 3) ? gqb : gqb + 128;
        v0 = v0 * sc * g[lane]; v1 = v1 * sc * g[lane + 64];
        if (grp >= 3) {
            const float partner = __shfl_xor(v0, 16);
            if (lane < 32) {
                const int i = lane & 15;
                const double inv = exp(-log(500000.0) * (double)i / 16.0);
                const double ang = pos * inv;
                const float cs = (float)cos(ang), sn = (float)sin(ang);
                v0 = (lane < 16) ? (v0 * cs - partner * sn) : (v0 * cs + partner * sn);
            }
        }
        if (RB) { v0 = rbf(v0); v1 = rbf(v1); }
        hp[lane] = v0; hp[lane + 64] = v1;
    }
    for (int u = wave; u < 17; u += 4) {
        float* hp = row + OFF_QI + u * 64;
        float v = hp[lane];
        const float partner = __shfl_xor(v, 8);
        if (lane < 16) {
            const int i = lane & 7;
            const double inv = exp(-log(500000.0) * (double)i / 8.0);
            const double ang = pos * inv;
            const float cs = (float)cos(ang), sn = (float)sin(ang);
            v = (lane < 8) ? (v * cs - partner * sn) : (v * cs + partner * sn);
        }
        if (RB) v = rbf(v);
        hp[lane] = v;
    }
}

__global__ __launch_bounds__(256) void k_mixa(const float* __restrict__ proj, const float* __restrict__ rel_bias  , float* __restrict__ out  ) {
    __shared__ float qs[4][128];
    __shared__ float ps[4][BAND];
    const int tid = threadIdx.x, wave = tid >> 6, lane = tid & 63;
    const int gid = blockIdx.x * 4 + wave;
    const int t = gid >> 3, h = gid & 7;
    const int b = t / S, s = t % S, c = s / CH, qi = s % CH;
    const float* qrow = proj + (size_t)t * NPROJ + OFF_QA + h * 128;
    qs[wave][lane] = qrow[lane]; qs[wave][lane + 64] = qrow[lane + 64];
    __syncthreads();
    float sc[9];
    float mx = -INFINITY;
#pragma unroll
    for (int i = 0; i < 9; ++i) {
        const int kj = lane + 64 * i;
        const int kp = (c - LEFT) * CH + kj;
        float v = -INFINITY;
        if (kp >= 0) {
            const float4* kr = (const float4*)(proj + (size_t)(b * S + kp) * NPROJ + OFF_KA + h * 128);
            float d = 0.f;
#pragma unroll 8
            for (int j = 0; j < 32; ++j) { const float4 kv = kr[j]; const float4 qv = *(const float4*)&qs[wave][j * 4]; d += kv.x * qv.x + kv.y * qv.y + kv.z * qv.z + kv.w * qv.w; }
            int dist = qi + LEFT * CH - kj;
            dist = dist < -MAXREL ? -MAXREL : (dist > MAXREL ? MAXREL : dist);
            v = d * 0.08838834764831845f + rel_bias[h * 257 + dist + MAXREL];
        }
        sc[i] = v; mx = fmaxf(mx, v);
    }
    mx = wmax(mx);
    float sum = 0.f;
#pragma unroll
    for (int i = 0; i < 9; ++i) { const float p = (sc[i] == -INFINITY) ? 0.f : expf(sc[i] - mx); sum += p; ps[wave][lane + 64 * i] = p; }
    sum = wsum(sum);
    __syncthreads();
    float a0 = 0.f, a1 = 0.f;
    for (int kj = 0; kj < BAND; ++kj) {
        const int kp = (c - LEFT) * CH + kj;
        if (kp < 0) continue;
        const float p = ps[wave][kj];
        const float* vr = proj + (size_t)(b * S + kp) * NPROJ + OFF_VA + h * 128;
        a0 += p * vr[lane]; a1 += p * vr[lane + 64];
    }
    const float inv = 1.0f / sum;
    out[(size_t)t * 2048 + h * 128 + lane] = a0 * inv;
    out[(size_t)t * 2048 + h * 128 + lane + 64] = a1 * inv;
}

__global__ __launch_bounds__(256) void k_dsa(const float* __restrict__ proj, float* __restrict__ out) {
    __shared__ float sc[4096];
    __shared__ float lg[4096];
    __shared__ float qis[16 * 64];
    __shared__ float wis[16];
    __shared__ float qh[128];
    __shared__ float redf[4];
    __shared__ int redi[4];
    __shared__ float acc2[256];
    const int t = blockIdx.x, tid = threadIdx.x, wave = tid >> 6, lane = tid & 63;
    const int b = t / S, s = t % S, c = s / CH;
    const int nadm = (c + 1) * CH;
    const float* prow = proj + (size_t)t * NPROJ;
    for (int i = tid; i < 1024; i += 256) qis[i] = prow[OFF_QI + i];
    if (tid < 16) wis[tid] = prow[OFF_WI + tid] * 0.25f;
    __syncthreads();
    for (int kp = tid; kp < nadm; kp += 256) {
        const float4* kr = (const float4*)(proj + (size_t)(b * S + kp) * NPROJ + OFF_KI);
        float4 k[16];
#pragma unroll
        for (int j = 0; j < 16; ++j) k[j] = kr[j];
        float score = 0.f;
        for (int h = 0; h < 16; ++h) {
            float d = 0.f;
#pragma unroll
            for (int j = 0; j < 16; ++j) { const float4 qv = *(const float4*)&qis[h * 64 + j * 4]; d += qv.x * k[j].x + qv.y * k[j].y + qv.z * k[j].z + qv.w * k[j].w; }
            score += wis[h] * fmaxf(d * 0.125f, 0.f);
        }
        sc[kp] = score;
    }
    __syncthreads();
    unsigned thr = 0u;
    if (nadm > TOPK) {
        for (int bit = 31; bit >= 0; --bit) {
            const unsigned cand = thr | (1u << bit);
            int local = 0;
            for (int kp = tid; kp < nadm; kp += 256) local += (skey(sc[kp]) >= cand) ? 1 : 0;
            local = wsumi(local);
            if (lane == 0) redi[wave] = local;
            __syncthreads();
            const int tot = redi[0] + redi[1] + redi[2] + redi[3];
            __syncthreads();
            if (tot >= TOPK) thr = cand;
        }
    }
    for (int h = 0; h < 8; ++h) {
        if (tid < 128) qh[tid] = prow[OFF_QB + h * 128 + tid];
        __syncthreads();
        float lmax = -INFINITY;
        for (int kp = tid; kp < nadm; kp += 256) {
            float l = -INFINITY;
            if (skey(sc[kp]) >= thr) {
                const float4* kr = (const float4*)(proj + (size_t)(b * S + kp) * NPROJ + OFF_KB + h * 128);
                float d = 0.f;
#pragma unroll 8
                for (int j = 0; j < 32; ++j) { const float4 kv = kr[j]; const float4 qv = *(const float4*)&qh[j * 4]; d += kv.x * qv.x + kv.y * qv.y + kv.z * qv.z + kv.w * qv.w; }
                l = d * 0.08838834764831845f;
            }
            lg[kp] = l; lmax = fmaxf(lmax, l);
        }
        lmax = wmax(lmax);
        if (lane == 0) redf[wave] = lmax;
        __syncthreads();
        const float m = fmaxf(fmaxf(redf[0], redf[1]), fmaxf(redf[2], redf[3]));
        __syncthreads();
        float lsum = 0.f;
        for (int kp = tid; kp < nadm; kp += 256) { const float l = lg[kp]; const float p = (l == -INFINITY) ? 0.f : expf(l - m); lg[kp] = p; lsum += p; }
        lsum = wsum(lsum);
        if (lane == 0) redf[wave] = lsum;
        __syncthreads();
        const float L = redf[0] + redf[1] + redf[2] + redf[3];
        const int d = tid & 127, half = tid >> 7;
        float a = 0.f;
        for (int kp = half; kp < nadm; kp += 2) {
            const float p = lg[kp];
            if (p != 0.f) a += p * proj[(size_t)(b * S + kp) * NPROJ + OFF_VB + h * 128 + d];
        }
        acc2[tid] = a;
        __syncthreads();
        if (tid < 128) out[(size_t)t * 2048 + 1024 + h * 128 + tid] = (acc2[tid] + acc2[tid + 128]) / L;
        __syncthreads();
    }
}

__global__ __launch_bounds__(256) void k_peer_route(const float* __restrict__ qv  , const float* __restrict__ subk  ,
                                                    int* __restrict__ expert, float* __restrict__ gate, unsigned* dbg_lists = nullptr) {
    __shared__ float qs[4][256];
    __shared__ float tv[4][2][16];
    __shared__ int ti[4][2][16];
    const int tid = threadIdx.x, wave = tid >> 6, lane = tid & 63;
    const int gid = blockIdx.x * 4 + wave;
    const int t = gid >> 3, h = gid & 7;
    const float* q = qv + (size_t)t * 2048 + h * 256;
#pragma unroll
    for (int j = 0; j < 4; ++j) qs[wave][lane + 64 * j] = q[lane + 64 * j];
    __syncthreads();
    for (int half = 0; half < 2; ++half) {
        float sv[2];
#pragma unroll
        for (int r = 0; r < 2; ++r) {
            const int n = lane + 64 * r;
            const float4* kr = (const float4*)(subk + ((size_t)half * 128 + n) * 128);
            float d = 0.f;
#pragma unroll 8
            for (int j = 0; j < 32; ++j) { const float4 kv = kr[j]; const float4 qq = *(const float4*)&qs[wave][half * 128 + j * 4]; d += kv.x * qq.x + kv.y * qq.y + kv.z * qq.z + kv.w * qq.w; }
            sv[r] = d;
        }
        for (int it = 0; it < 16; ++it) {
            float bv; int bi;
            if (sv[0] >= sv[1]) { bv = sv[0]; bi = lane; } else { bv = sv[1]; bi = lane + 64; }
#pragma unroll
            for (int o = 32; o > 0; o >>= 1) {
                const float ov = __shfl_xor(bv, o); const int oi = __shfl_xor(bi, o);
                if (ov > bv || (ov == bv && oi < bi)) { bv = ov; bi = oi; }
            }
            if (lane == 0) { tv[wave][half][it] = bv; ti[wave][half][it] = bi; }
            if (bi == lane) sv[0] = -INFINITY;
            if (bi == lane + 64) sv[1] = -INFINITY;
        }
    }
    __syncthreads();
#ifdef NAIVE_EXPORT_LISTS
    if (lane < 32) NAIVE_EXPORT_LISTS[((size_t)t * 8 + h) * 32 + lane] = 127u - (unsigned)ti[wave][lane >> 4][lane & 15];
#endif
    float cv[4];
#pragma unroll
    for (int r = 0; r < 4; ++r) { const int ci = lane * 4 + r; cv[r] = tv[wave][0][ci >> 4] + tv[wave][1][ci & 15]; }
    float scv = 0.f; int sci = 0;
    for (int it = 0; it < 16; ++it) {
        float bv = cv[0]; int bi = lane * 4;
#pragma unroll
        for (int r = 1; r < 4; ++r) if (cv[r] > bv) { bv = cv[r]; bi = lane * 4 + r; }
#pragma unroll
        for (int o = 32; o > 0; o >>= 1) {
            const float ov = __shfl_xor(bv, o); const int oi = __shfl_xor(bi, o);
            if (ov > bv || (ov == bv && oi < bi)) { bv = ov; bi = oi; }
        }
        if (lane == it) { scv = bv; sci = bi; }
#pragma unroll
        for (int r = 0; r < 4; ++r) if (bi == lane * 4 + r) cv[r] = -INFINITY;
    }
    const float mx = __shfl(scv, 0);
    float e = (lane < 16) ? expf(scv - mx) : 0.f;
    const float sum = wsum(e);
    if (lane < 16) {
        const int e1 = ti[wave][0][sci >> 4], e2 = ti[wave][1][sci & 15];
        expert[(size_t)t * 128 + h * 16 + lane] = e1 * 128 + e2;
        gate[(size_t)t * 128 + h * 16 + lane] = e / sum;
    }
}

__device__ __forceinline__ float gelu_tanh(float x) {
    const float u = 0.7978845608028654f * (x + 0.044715f * x * x * x);
    return 0.5f * x * (1.0f + tanhf(u));
}

__global__ __launch_bounds__(256) void k_peer_experts(const float* __restrict__ xn, const int* __restrict__ expert, const float* __restrict__ gate,
                                                      const float* __restrict__ U, const float* __restrict__ V, const float* __restrict__ hin, float* __restrict__ hout) {
    __shared__ float xs[2048];
    __shared__ float coef[128];
    __shared__ int eid[128];
    const int t = blockIdx.x, tid = threadIdx.x, wave = tid >> 6, lane = tid & 63;
    for (int i = tid; i < 2048; i += 256) xs[i] = xn[(size_t)t * 2048 + i];
    if (tid < 128) eid[tid] = expert[(size_t)t * 128 + tid];
    __syncthreads();
    for (int k = wave; k < 128; k += 4) {
        const float4* ur = (const float4*)(U + (size_t)eid[k] * 2048);
        float d = 0.f;
#pragma unroll
        for (int j = 0; j < 8; ++j) { const float4 uv = ur[lane + 64 * j]; const float4 xv = *(const float4*)&xs[(lane + 64 * j) * 4]; d += uv.x * xv.x + uv.y * xv.y + uv.z * xv.z + uv.w * xv.w; }
        d = wsum(d);
        if (lane == 0) coef[k] = gate[(size_t)t * 128 + k] * gelu_tanh(d);
    }
    __syncthreads();
    float4 a0 = make_float4(0.f, 0.f, 0.f, 0.f), a1 = a0;
    for (int k = 0; k < 128; ++k) {
        const float cf = coef[k];
        const float4* vr = (const float4*)(V + (size_t)eid[k] * 2048);
        const float4 v0 = vr[tid], v1 = vr[tid + 256];
        a0.x += cf * v0.x; a0.y += cf * v0.y; a0.z += cf * v0.z; a0.w += cf * v0.w;
        a1.x += cf * v1.x; a1.y += cf * v1.y; a1.z += cf * v1.z; a1.w += cf * v1.w;
    }
    const float4* hi = (const float4*)(hin + (size_t)t * 2048);
    float4* ho = (float4*)(hout + (size_t)t * 2048);
    const float4 h0 = hi[tid], h1 = hi[tid + 256];
    ho[tid] = make_float4(h0.x + a0.x, h0.y + a0.y, h0.z + a0.z, h0.w + a0.w);
    ho[tid + 256] = make_float4(h1.x + a1.x, h1.y + a1.y, h1.z + a1.z, h1.w + a1.w);
}

__global__ __launch_bounds__(256) void k_ple_final(float* __restrict__ out, const float* __restrict__ gp, const float* __restrict__ pp, size_t n4) {
    for (size_t i = (size_t)blockIdx.x * blockDim.x + threadIdx.x; i < n4; i += (size_t)gridDim.x * blockDim.x) {
        float4 o = ((float4*)out)[i]; const float4 g = ((const float4*)gp)[i], q = ((const float4*)pp)[i];
        o.x += q.x / (1.0f + expf(-g.x)); o.y += q.y / (1.0f + expf(-g.y)); o.z += q.z / (1.0f + expf(-g.z)); o.w += q.w / (1.0f + expf(-g.w));
        ((float4*)out)[i] = o;
    }
}

struct Bufs { float *hn, *proj, *att, *h1, *qv, *gp, *pp; int* expert; float* gate; };
inline Bufs carve(void* d_ws) {
    char* w = (char*)d_ws; const size_t MiB = 1u << 20;
    Bufs b;
    b.hn = (float*)(w + 0);
    b.proj = (float*)(w + 64 * MiB);
    b.att = (float*)(w + 304 * MiB);
    b.h1 = (float*)(w + 368 * MiB);
    b.qv = (float*)(w + 64 * MiB);
    b.gp = (float*)(w + 128 * MiB);
    b.pp = (float*)(w + 192 * MiB);
    b.expert = (int*)(w + 256 * MiB);
    b.gate = (float*)(w + 260 * MiB);
    return b;
}

inline void run_stages(void* const* d_in, void* d_out, const Bufs& b, int from, int to, hipStream_t st) {
    const float* x = (const float*)d_in[0]; const float* p = (const float*)d_in[1]; const int* positions = (const int*)d_in[2];
    const float* norm_mix = (const float*)d_in[3]; const float* w_in = (const float*)d_in[4];
    const float* gqa = (const float*)d_in[5]; const float* gqb = (const float*)d_in[6]; const float* rel_bias = (const float*)d_in[7];
    const float* w_out = (const float*)d_in[8]; const float* norm_ffn = (const float*)d_in[9]; const float* peer_query = (const float*)d_in[10];
    const float* subk = (const float*)d_in[11]; const float* U = (const float*)d_in[12]; const float* V = (const float*)d_in[13];
    const float* norm_ple = (const float*)d_in[14]; const float* ple_gate = (const float*)d_in[15]; const float* ple_proj = (const float*)d_in[16];
    float* out = (float*)d_out;
#define ST(k) (from <= (k) && (k) < to)
    if (ST(0)) {
        k_rmsnorm<<<T, 256, 0, st>>>(x, norm_mix, b.hn);
        if (NAIVE_RB) { k_sgemm<false, true><<<dim3((NPROJ + 127) / 128, T / 128), 256, 0, st>>>(b.hn, w_in, b.proj, nullptr, T, NPROJ, D); k_postproj<true><<<T, 256, 0, st>>>(b.proj, positions, gqa, gqb); }
        else { k_sgemm<false><<<dim3((NPROJ + 127) / 128, T / 128), 256, 0, st>>>(b.hn, w_in, b.proj, nullptr, T, NPROJ, D); k_postproj<false><<<T, 256, 0, st>>>(b.proj, positions, gqa, gqb); }
    }
    if (ST(1)) {
        k_mixa<<<T * 8 / 4, 256, 0, st>>>(b.proj, rel_bias, b.att);
        k_dsa<<<T, 256, 0, st>>>(b.proj, b.att);
    }
    if (ST(2)) k_sgemm<true><<<dim3(D / 128, T / 128), 256, 0, st>>>(b.att, w_out, b.h1, x, T, D, D);
    if (ST(3)) {
        k_rmsnorm<<<T, 256, 0, st>>>(b.h1, norm_ffn, b.hn);
        k_sgemm<false><<<dim3(D / 128, T / 128), 256, 0, st>>>(b.hn, peer_query, b.qv, nullptr, T, D, D);
        k_peer_route<<<T * 8 / 4, 256, 0, st>>>(b.qv, subk, b.expert, b.gate);
        k_peer_experts<<<T, 256, 0, st>>>(b.hn, b.expert, b.gate, U, V, b.h1, out);
    }
    if (ST(4)) {
        k_rmsnorm<<<T, 256, 0, st>>>(out, norm_ple, b.hn);
        k_sgemm<false><<<dim3(D / 128, T / 128), 256, 0, st>>>(b.hn, ple_gate, b.gp, nullptr, T, D, D);
        k_sgemm<false><<<dim3(D / 128, T / 128), 256, 0, st>>>(p, ple_proj, b.pp, nullptr, T, D, PLE);
        k_ple_final<<<2048, 256, 0, st>>>(out, b.gp, b.pp, (size_t)T * D / 4);
    }
#undef ST
}
inline void run(void* const* d_in, void* d_out, void* d_ws, hipStream_t st) { run_stages(d_in, d_out, carve(d_ws), 0, 5, st); }
inline Bufs carve_hybrid(void* d_ws) {
    char* w = (char*)d_ws; const size_t MiB = 1u << 20;
    Bufs b;
    b.proj = (float*)(w + 0); b.att = (float*)(w + 228 * MiB); b.h1 = (float*)(w + 292 * MiB); b.hn = (float*)(w + 356 * MiB);
    b.qv = (float*)(w + 0); b.gp = (float*)(w + 64 * MiB); b.pp = (float*)(w + 128 * MiB); b.expert = (int*)(w + 192 * MiB); b.gate = (float*)(w + 196 * MiB);
    return b;
}
}
namespace pg8 {
#define PG8_LAS __attribute__((address_space(3)))
typedef unsigned short bf16_t;
typedef short bf16x8 __attribute__((ext_vector_type(8)));
typedef float f32x4 __attribute__((ext_vector_type(4)));
typedef unsigned u32x4 __attribute__((ext_vector_type(4)));
constexpr int BM = 256, BK = 64, HALF = 128, HTB = HALF * BK * 2  , STAGE_BYTES = 8 * HTB, NXCD = 8, WGM = 8;

__host__ __device__ __forceinline__ int lds_byte(int r, int c) { const int st = (r >> 4) * 2 + (c >> 5), rr = r & 15, cc = c & 31, ob = rr * 64 + cc * 2; return st * 1024 + (ob ^ (((ob >> 9) & 1) << 5)); }
__host__ __device__ __forceinline__ void stage_rc(int b, int& R, int& C) { const int st = b / 1024, sb = b % 1024, swz = sb ^ (((sb >> 9) & 1) << 5); R = (st >> 1) * 16 + swz / 64; C = (st & 1) * 32 + (swz % 64) / 2; }
__host__ __device__ __forceinline__ int perm32(int rho) { const int n = rho >> 4, i = rho & 15; return 8 * (i >> 2) + 4 * n + (i & 3); }

struct Unit { int pm, pn; };
struct Gemm { const bf16_t* A; const bf16_t* Bt; int M, N, K; };

struct StaticOrder {
    int nM, nN, nwg, G, c;
    __host__ __device__ void init(int M, int N, int G_, int c_) { nM = M / BM; nN = N / BM; nwg = nM * nN; G = G_; c = c_; }
    __host__ __device__ bool next(int i, Unit& u) const {
        const long L = (long)i * G + c; if (L >= nwg) return false;
        int wgid = (int)L; { const int q = nwg / NXCD, r = nwg % NXCD, xcd = wgid % NXCD, off = wgid / NXCD; wgid = (xcd < r ? xcd * (q + 1) : r * (q + 1) + (xcd - r) * q) + off; }
        const int nig = WGM * nN, gid = wgid / nig, fm = gid * WGM, gsz = (nM - fm) < WGM ? (nM - fm) : WGM;
        u.pm = fm + ((wgid % nig) % gsz); u.pn = (wgid % nig) / gsz; return true;
    }
    __device__ __forceinline__ void a_ready(const Unit&) const {}
    __device__ __forceinline__ void done(const Unit&) const {}
};
__device__ __forceinline__ unsigned cvt_pk_bf16(float lo, float hi) { unsigned r; asm volatile("v_cvt_pk_bf16_f32 %0, %1, %2" : "=v"(r) : "v"(lo), "v"(hi)); return r; }
typedef float f32x2 __attribute__((ext_vector_type(2)));
typedef int i32x4 __attribute__((ext_vector_type(4)));
template <bool I8> struct AccSel { typedef f32x4 type; };
template <> struct AccSel<true> { typedef i32x4 type; };
template <bool I8> __device__ __forceinline__ typename AccSel<I8>::type mma1(const bf16x8& b, const bf16x8& a, const typename AccSel<I8>::type& c) {
    if constexpr (I8) return __builtin_amdgcn_mfma_i32_16x16x64_i8(__builtin_bit_cast(i32x4, b), __builtin_bit_cast(i32x4, a), c, 0, 0, 0);
    else return __builtin_amdgcn_mfma_f32_16x16x32_bf16(b, a, c, 0, 0, 0);
}
template <class Epi, class Sched, bool ALIGN_EPI = false, bool SP2 = false, bool I8 = false>
__device__ __forceinline__ void gemm_phase(PG8_LAS unsigned char* lds, const Gemm g, const Sched& S, const Epi& E) {
    int tid_ = threadIdx.x; asm volatile("" : "+v"(tid_));
    const int tid = tid_, wid = __builtin_amdgcn_readfirstlane(tid >> 6), lane = tid & 63, wr = wid >> 2, wc = wid & 3, fr = lane & 15, fq = lane >> 4;
    const int K = g.K, nt = K / BK;
    unsigned voffA[2], voffB[2];
#pragma unroll
    for (int i = 0; i < 2; ++i) { int R, C; stage_rc(tid * 16 + i * 8192, R, C); const int Rb = Epi::PERM ? ((R & ~31) + perm32(R & 31)) : R;
        voffA[i] = (unsigned)(R * K + C) * 2u; voffB[i] = (unsigned)(Rb * K + C) * 2u; }
    const size_t kstep = (size_t)(BK * 2);
    const size_t hstep = (size_t)HALF * K * 2;
    const size_t tstep = 2 * hstep;
    const unsigned ldsw = (unsigned)wid * 1024u;
    const int aoff = lds_byte(wr * 64 + fr, fq * 8), boff = lds_byte(wc * 32 + fr, fq * 8);
#define PG8_SA(b, h) (((b) * 2 + (h)) * HTB)
#define PG8_SB(b, h) ((4 + (b) * 2 + (h)) * HTB)
#define PG8_STAGE(bufoff, gbase, voff) do { _Pragma("unroll") for (int _i = 0; _i < 2; ++_i) \
        __builtin_amdgcn_global_load_lds((const unsigned*)((const char*)(gbase) + (voff)[_i]), (PG8_LAS unsigned*)(lds + (bufoff) + ldsw + _i * 8192), 16, 0, 0); } while (0)
#define PG8_LDA(dst, b, h) do { _Pragma("unroll") for (int m = 0; m < 4; ++m) _Pragma("unroll") for (int k = 0; k < 2; ++k) dst[m][k] = *(const PG8_LAS bf16x8*)(lds + PG8_SA(b, h) + aoff + m * 2048 + k * 1024); } while (0)
#define PG8_LDB(dst, b, h) do { _Pragma("unroll") for (int n = 0; n < 2; ++n) _Pragma("unroll") for (int k = 0; k < 2; ++k) dst[n][k] = *(const PG8_LAS bf16x8*)(lds + PG8_SB(b, h) + boff + n * 2048 + k * 1024); } while (0)
#define PG8_MMA(ai, bj, At, Bt) do { __builtin_amdgcn_s_setprio(1); _Pragma("unroll") for (int m = 0; m < 4; ++m) _Pragma("unroll") for (int n = 0; n < 2; ++n) _Pragma("unroll") for (int k = 0; k < 2; ++k) \
        acc[ai][bj][m][n] = mma1<I8>(Bt[n][k], At[m][k], acc[ai][bj][m][n]); __builtin_amdgcn_s_setprio(0); } while (0)
#define PG8_WAIT_V(n) asm volatile("s_waitcnt vmcnt(" #n ")" ::: "memory")
#define PG8_WAIT_L(n) asm volatile("s_waitcnt lgkmcnt(" #n ")" ::: "memory")
#define PG8_BAR __builtin_amdgcn_s_barrier()
#define PG8_SCHED __builtin_amdgcn_sched_barrier(0)
    Unit cur, nxt; int ui = 0;
    if (!S.next(0, cur)) return;
    typedef typename AccSel<I8>::type acc_t;
    acc_t acc[2][2][4][2];
#pragma unroll
    for (int a = 0; a < 2; ++a)
#pragma unroll
        for (int b = 0; b < 2; ++b)
#pragma unroll
            for (int m = 0; m < 4; ++m)
#pragma unroll
                for (int n = 0; n < 2; ++n) acc[a][b][m][n] = acc_t{};
    bf16x8 At[4][2], B0[2][2], B1[2][2];
    const char* cA = (const char*)g.A + (size_t)cur.pm * tstep; const char* cB = (const char*)g.Bt + (size_t)cur.pn * tstep;
    S.a_ready(cur);
    if constexpr (SP2) {
        PG8_STAGE(PG8_SB(0, 0), cB, voffB); PG8_STAGE(PG8_SB(0, 1), cB + hstep, voffB); PG8_STAGE(PG8_SA(0, 0), cA, voffA); PG8_STAGE(PG8_SA(0, 1), cA + hstep, voffA);
        if (wr == 1) PG8_BAR;
        PG8_WAIT_V(2); PG8_BAR;
        PG8_STAGE(PG8_SB(1, 0), cB + kstep, voffB); PG8_STAGE(PG8_SA(1, 0), cA + kstep, voffA); PG8_STAGE(PG8_SB(1, 1), cB + hstep + kstep, voffB);
        PG8_WAIT_V(6); PG8_BAR;
    } else {
        PG8_STAGE(PG8_SB(0, 0), cB, voffB); PG8_STAGE(PG8_SA(0, 0), cA, voffA); PG8_STAGE(PG8_SB(0, 1), cB + hstep, voffB); PG8_STAGE(PG8_SA(0, 1), cA + hstep, voffA);
        if (wr == 1) PG8_BAR;
        PG8_WAIT_V(4); PG8_BAR;
        PG8_STAGE(PG8_SB(1, 0), cB + kstep, voffB); PG8_STAGE(PG8_SA(1, 0), cA + kstep, voffA); PG8_STAGE(PG8_SB(1, 1), cB + hstep + kstep, voffB);
        PG8_WAIT_V(6); PG8_BAR;
    }
    for (;;) {
        const bool has_next = S.next(ui + 1, nxt);
        const char* nA = has_next ? (const char*)g.A + (size_t)nxt.pm * tstep : cA; const char* nB = has_next ? (const char*)g.Bt + (size_t)nxt.pn * tstep : cB;
        for (int t = 0; t < nt; t += 2) {
            const bool last = (t == nt - 2);
            const char* a1 = cA + (size_t)(t + 1) * kstep;
            const char* a2 = last ? nA : cA + (size_t)(t + 2) * kstep; const char* b2 = last ? nB : cB + (size_t)(t + 2) * kstep;
            const char* a3 = a2 + kstep; const char* b3 = b2 + kstep;
            if (last && has_next) S.a_ready(nxt);
            if constexpr (SP2) {
            PG8_LDB(B0, 0, 0); PG8_LDB(B1, 0, 1); PG8_SCHED; PG8_LDA(At, 0, 0); PG8_STAGE(PG8_SA(1, 1), a1 + hstep, voffA);
            PG8_WAIT_V(8); PG8_WAIT_L(0); PG8_BAR; PG8_MMA(0, 0, At, B0); PG8_MMA(0, 1, At, B1); PG8_BAR; PG8_SCHED;
            PG8_LDA(At, 0, 1); PG8_STAGE(PG8_SB(0, 0), b2, voffB); PG8_STAGE(PG8_SB(0, 1), b2 + hstep, voffB); PG8_STAGE(PG8_SA(0, 0), a2, voffA);
            PG8_WAIT_V(8); PG8_WAIT_L(0); PG8_BAR; PG8_MMA(1, 0, At, B0); PG8_MMA(1, 1, At, B1); PG8_BAR; PG8_SCHED;
            PG8_LDB(B0, 1, 0); PG8_LDB(B1, 1, 1); PG8_SCHED; PG8_LDA(At, 1, 0); PG8_STAGE(PG8_SA(0, 1), a2 + hstep, voffA);
            PG8_WAIT_V(8); PG8_WAIT_L(0); PG8_BAR; PG8_MMA(0, 0, At, B0); PG8_MMA(0, 1, At, B1); PG8_BAR; PG8_SCHED;
            PG8_LDA(At, 1, 1); PG8_STAGE(PG8_SB(1, 0), b3, voffB); PG8_STAGE(PG8_SB(1, 1), b3 + hstep, voffB); PG8_STAGE(PG8_SA(1, 0), a3, voffA);
            PG8_WAIT_V(8); PG8_WAIT_L(0); PG8_BAR; PG8_MMA(1, 0, At, B0); PG8_MMA(1, 1, At, B1); PG8_BAR; PG8_SCHED;
            } else {
            PG8_LDB(B0, 0, 0); PG8_SCHED; PG8_LDA(At, 0, 0); PG8_STAGE(PG8_SA(1, 1), a1 + hstep, voffA);
            PG8_WAIT_L(8); PG8_BAR; PG8_WAIT_L(0); PG8_MMA(0, 0, At, B0); PG8_BAR; PG8_SCHED;
            PG8_LDB(B1, 0, 1); PG8_STAGE(PG8_SB(0, 0), b2, voffB);
            PG8_BAR; PG8_WAIT_L(0); PG8_MMA(0, 1, At, B1); PG8_BAR;
            PG8_LDA(At, 0, 1); PG8_STAGE(PG8_SA(0, 0), a2, voffA);
            PG8_BAR; PG8_WAIT_L(0); PG8_MMA(1, 0, At, B0); PG8_BAR; PG8_SCHED;
            PG8_STAGE(PG8_SB(0, 1), b2 + hstep, voffB);
            PG8_WAIT_V(6); PG8_BAR; PG8_MMA(1, 1, At, B1); PG8_BAR;
            PG8_LDB(B0, 1, 0); PG8_SCHED; PG8_LDA(At, 1, 0); PG8_STAGE(PG8_SA(0, 1), a2 + hstep, voffA);
            PG8_WAIT_L(8); PG8_BAR; PG8_WAIT_L(0); PG8_MMA(0, 0, At, B0); PG8_BAR; PG8_SCHED;
            PG8_LDB(B1, 1, 1); PG8_STAGE(PG8_SB(1, 0), b3, voffB);
            PG8_BAR; PG8_WAIT_L(0); PG8_MMA(0, 1, At, B1); PG8_BAR;
            PG8_LDA(At, 1, 1); PG8_STAGE(PG8_SA(1, 0), a3, voffA);
            PG8_BAR; PG8_WAIT_L(0); PG8_MMA(1, 0, At, B0); PG8_BAR; PG8_SCHED;
            PG8_STAGE(PG8_SB(1, 1), b3 + hstep, voffB);
            PG8_WAIT_V(6); PG8_BAR; PG8_MMA(1, 1, At, B1); PG8_BAR;
            }
        }
        if constexpr (ALIGN_EPI) { if (wr == 0) PG8_BAR; }
        if constexpr (!Epi::AFTER_DRAIN) { E(acc, cur, wr, wc, fr, fq); S.done(cur); }
        if (!has_next) break;
#pragma unroll
        for (int a = 0; a < 2; ++a)
#pragma unroll
            for (int b = 0; b < 2; ++b)
#pragma unroll
                for (int m = 0; m < 4; ++m)
#pragma unroll
                    for (int n = 0; n < 2; ++n) acc[a][b][m][n] = acc_t{};
        cur = nxt; cA = nA; cB = nB; ++ui;
        if constexpr (ALIGN_EPI) { if (wr == 1) PG8_BAR; }
    }
    PG8_WAIT_V(0);
    if constexpr (!ALIGN_EPI) { if (wr == 0) PG8_BAR; }
    PG8_BAR;
    if constexpr (Epi::AFTER_DRAIN) { E.fused(acc, cur, wr, wc, fr, fq, lds, wid, lane); S.done(cur); }
#undef PG8_SA
#undef PG8_SB
#undef PG8_STAGE
#undef PG8_LDA
#undef PG8_LDB
#undef PG8_MMA
#undef PG8_WAIT_V
#undef PG8_WAIT_L
#undef PG8_BAR
#undef PG8_SCHED
}
}
#include <hip/hip_cooperative_groups.h>
namespace fk {
using namespace cfg;
namespace cg = cooperative_groups;
#define LAS __attribute__((address_space(3)))
typedef unsigned short bf16_t;
typedef short bf16x8 __attribute__((ext_vector_type(8)));
typedef short s16x4 __attribute__((ext_vector_type(4)));
typedef float f32x4 __attribute__((ext_vector_type(4)));
typedef float f32x2 __attribute__((ext_vector_type(2)));
typedef float f32x16 __attribute__((ext_vector_type(16)));
typedef unsigned u32x4 __attribute__((ext_vector_type(4)));
typedef unsigned u32x2 __attribute__((ext_vector_type(2)));

constexpr int NWAVES = 8, NTHR = 512;
constexpr int LDS_BYTES = 160 * 1024;
constexpr int RING_BYTES = 131072;
constexpr int EPI_OFF = RING_BYTES;
constexpr int NPAD = 7424;

constexpr size_t MiB = 1u << 20;
constexpr size_t WS_CTL_BYTES = 128 * 1024;
constexpr size_t WS_BAR = 0;
constexpr size_t WS_WIN = 1 * MiB;
constexpr size_t WS_WOUT = 30 * MiB;
constexpr size_t WS_WPQ = 38 * MiB;
constexpr size_t WS_WG = 46 * MiB;
constexpr size_t WS_WP = 54 * MiB;
constexpr size_t WS_SUBK = 55 * MiB;
constexpr size_t WS_ROPE = 56 * MiB;
constexpr size_t WS_RS1 = 58 * MiB;
constexpr size_t WS_SCL = 59 * MiB;
constexpr size_t WS_RS3 = 60 * MiB;
constexpr size_t WS_UB = 64 * MiB;
constexpr size_t WS_VB = 128 * MiB;
constexpr size_t WS_XB = 192 * MiB;
constexpr size_t WS_QA = 224 * MiB, WS_KA = 240 * MiB, WS_VA = 256 * MiB, WS_QB = 272 * MiB, WS_KB = 288 * MiB, WS_VBB = 304 * MiB;
constexpr size_t WS_QI = 320 * MiB;
constexpr size_t WS_KI = 336 * MiB;
constexpr size_t WS_WI = 337 * MiB;
constexpr size_t WS_BM = 338 * MiB;
constexpr size_t WS_SC = 342 * MiB;
constexpr size_t WS_O = 470 * MiB;
constexpr size_t WS_H1 = 342 * MiB;
constexpr size_t WS_H1B = 406 * MiB;
constexpr size_t WS_X8 = 438 * MiB;
constexpr size_t WS_GATE = 454 * MiB;
constexpr size_t WS_EXP = 458 * MiB;
constexpr size_t WS_CP = 462 * MiB;
constexpr size_t WS_SX = 466 * MiB;
constexpr size_t WS_SSQP = 467 * MiB;
constexpr size_t WS_QCNT = 64 * 1024;
constexpr size_t WS_PB = 502 * MiB;
constexpr size_t WS_PP = 224 * MiB;
constexpr size_t WS_X8IN = 342 * MiB;
constexpr size_t WS_W8IN = 358 * MiB;
constexpr size_t WS_SWIN = 374 * MiB;
constexpr size_t WS_WG8 = 376 * MiB;
constexpr size_t WS_SWG = 380 * MiB;
constexpr size_t WS_H2Q = 382 * MiB;
constexpr size_t WS_SAH2 = 398 * MiB;
constexpr size_t WS_WPQ8 = 399 * MiB;
constexpr size_t WS_SWPQ = 403 * MiB;
constexpr size_t WS_AMAX1 = 398 * MiB + 65536;
constexpr size_t WS_END = 506 * MiB;

__device__ __forceinline__ unsigned f2bf(float f) { unsigned u = __builtin_bit_cast(unsigned, f); return (u + 0x7fffu + ((u >> 16) & 1u)) >> 16; }
__device__ __forceinline__ unsigned pk2(float lo, float hi) { return f2bf(lo) | (f2bf(hi) << 16); }
__device__ __forceinline__ float bf2f(unsigned short b) { return __builtin_bit_cast(float, (unsigned)b << 16); }
__device__ __forceinline__ float wave_sum(float v) {
#pragma unroll
    for (int o = 1; o < 64; o <<= 1) v += __shfl_xor(v, o);
    return v;
}
#define LDS_WAIT() asm volatile("s_waitcnt lgkmcnt(0)" ::: "memory")

struct Args {
    const float* in[17];
    float* out;
    unsigned char* ws;
    int ph_lo, ph_hi, rep_phase, pad;
};

struct Ctx {
    int tid, lane, wave, G, vcu, bid;
    LAS unsigned char* lds;
};
#define XB_TMO      128
#define XB_XCNT(j)  (256  + 64 * (j))
#define XB_XSUB(j)  (1280 + 64 * (j))
#define XB_XGEN(j)  (2304 + 64 * (j))
#define XB_TOP      3328
#define XB_TOPGEN   3392
#define XCD_BAR_WORDS 3456
#define XB_SPIN_CAP (1u << 18)

__device__ __forceinline__ unsigned xb_ld(unsigned* p)              { return __hip_atomic_load(p, __ATOMIC_RELAXED, __HIP_MEMORY_SCOPE_AGENT); }
__device__ __forceinline__ unsigned xb_add(unsigned* p, unsigned v) { return __hip_atomic_fetch_add(p, v, __ATOMIC_RELAXED, __HIP_MEMORY_SCOPE_AGENT); }
__device__ __forceinline__ unsigned xb_xcc_id() { return (unsigned)__builtin_amdgcn_s_getreg((3 << 11) | 20) & 0xFu; }
#define XB_SPIN(cond, bar) do { unsigned _sp = 0; while (cond) { __builtin_amdgcn_s_sleep(1); \
    if ((++_sp & 255u) == 0u) { if (xb_ld(&(bar)[XB_TMO])) break; if (_sp > XB_SPIN_CAP) { atomicAdd(&(bar)[XB_TMO], 1u); break; } } } } while (0)

struct XcdBarrier {
    unsigned* bar; unsigned x;
    volatile LAS unsigned* st;
};

__device__ __forceinline__ XcdBarrier xcd_barrier_post(unsigned* bar, volatile LAS unsigned* st) {
    XcdBarrier b; b.bar = bar; b.x = xb_xcc_id(); b.st = st;
    if (threadIdx.x == 0) (void)xb_add(&bar[XB_XCNT(b.x)], 1u);
    return b;
}
__device__ __forceinline__ void xcd_barrier_complete(unsigned* bar, unsigned x, unsigned& nloc, unsigned& nx) {
    const unsigned G = gridDim.x * gridDim.y * gridDim.z;
    unsigned sum, cnt, mine, sp = 0u;
    for (;;) {
        sum = 0u; cnt = 0u; mine = 0u;
#pragma unroll
        for (unsigned j = 0; j < 16; ++j) { const unsigned c = xb_ld(&bar[XB_XCNT(j)]); sum += c; cnt += (c > 0u) ? 1u : 0u; mine = (j == x) ? c : mine; }
        if (sum == G) break;
        __builtin_amdgcn_s_sleep(1);
        if ((++sp & 255u) == 0u) { if (xb_ld(&bar[XB_TMO])) break; if (sp > XB_SPIN_CAP) { atomicAdd(&bar[XB_TMO], 1u); break; } }
    }
    nloc = mine > 0u ? mine : 1u; nx = cnt > 0u ? cnt : 1u;
}

__device__ __forceinline__ void xcd_barrier(const XcdBarrier& b) {
    asm volatile("s_waitcnt vmcnt(0)" ::: "memory");
    __syncthreads();
    if (threadIdx.x == 0) {
        unsigned* bar = b.bar;
        __builtin_amdgcn_s_waitcnt(0);
        unsigned nloc = b.st[0], nx = b.st[1];
        if (nloc == 0u) { xcd_barrier_complete(bar, b.x, nloc, nx); b.st[0] = nloc; b.st[1] = nx; }
        const unsigned old = xb_add(&bar[XB_XSUB(b.x)], 1u);
        const unsigned gen = old / nloc;
        if (old + 1u == (gen + 1u) * nloc) {
            __builtin_amdgcn_fence(__ATOMIC_RELEASE, "agent");
            asm volatile("s_waitcnt vmcnt(0)" ::: "memory");
            const unsigned og = xb_add(&bar[XB_TOP], 1u);
            const unsigned tg = og / nx;
            if (og + 1u == (tg + 1u) * nx) xb_add(&bar[XB_TOPGEN], 1u);
            else XB_SPIN(xb_ld(&bar[XB_TOPGEN]) == tg, bar);
            __builtin_amdgcn_fence(__ATOMIC_ACQUIRE, "agent");
            xb_add(&bar[XB_XGEN(b.x)], 1u);
            asm volatile("s_waitcnt vmcnt(0)" ::: "memory");
        } else {
            XB_SPIN(xb_ld(&bar[XB_XGEN(b.x)]) == gen, bar);
            __builtin_amdgcn_fence(__ATOMIC_ACQUIRE, "agent");
            asm volatile("s_waitcnt vmcnt(0)" ::: "memory");
        }
    }
    __syncthreads();
}

__device__ __forceinline__ void p0_transpose_item(const float* __restrict__ W, const float* __restrict__ g, int K, int N, bf16_t* __restrict__ WT, LAS float* scr, int item, int nblk, int lane) {
    const int kb = item / nblk, nb = item % nblk, k0 = 64 * kb, n0 = 32 * nb;
    const int n = n0 + 4 * (lane & 7);
#pragma unroll
    for (int i = 0; i < 8; ++i) {
        const int kk = 8 * i + (lane >> 3);
        f32x4 v = (n < N) ? *(const f32x4*)(W + (size_t)(k0 + kk) * N + n) : (f32x4){0.f, 0.f, 0.f, 0.f};
        if (g) v = v * g[k0 + kk];
        LAS float* d = scr + kk * 33 + 4 * (lane & 7);
        d[0] = v.x; d[1] = v.y; d[2] = v.z; d[3] = v.w;
    }
    LDS_WAIT(); asm volatile("" ::: "memory");
    const int c = lane & 7;
#pragma unroll
    for (int j = 0; j < 4; ++j) {
        const int nn = (lane >> 3) + 8 * j; const LAS float* s = scr + (8 * c) * 33 + nn;
        u32x4 o; o.x = pk2(s[0 * 33], s[1 * 33]); o.y = pk2(s[2 * 33], s[3 * 33]); o.z = pk2(s[4 * 33], s[5 * 33]); o.w = pk2(s[6 * 33], s[7 * 33]);
        *(u32x4*)(WT + (size_t)(n0 + nn) * K + k0 + 8 * c) = o;
    }
    LDS_WAIT(); asm volatile("" ::: "memory");
}

__device__ __forceinline__ void p0_quant_row(const bf16_t* __restrict__ src, unsigned char* __restrict__ dst, float* __restrict__ scl, int lane) {
    const u32x4* r = (const u32x4*)src + 2 * lane;
    u32x4 w[4]; float mx = 0.f;
#pragma unroll
    for (int j = 0; j < 2; ++j) { w[2 * j] = r[128 * j]; w[2 * j + 1] = r[128 * j + 1]; }
    float f[32];
#pragma unroll
    for (int j = 0; j < 4; ++j) { const unsigned u[4] = {w[j].x, w[j].y, w[j].z, w[j].w};
#pragma unroll
        for (int q = 0; q < 4; ++q) { f[8 * j + 2 * q] = __uint_as_float(u[q] << 16); f[8 * j + 2 * q + 1] = __uint_as_float(u[q] & 0xffff0000u); } }
#pragma unroll
    for (int i = 0; i < 32; ++i) mx = fmaxf(mx, fabsf(f[i]));
#pragma unroll
    for (int o = 1; o < 64; o <<= 1) mx = fmaxf(mx, __shfl_xor(mx, o));
    const float inv = mx > 0.f ? 127.0f / mx : 0.f;
    if (lane == 0) *scl = mx * (1.0f / 127.0f);
#pragma unroll
    for (int j = 0; j < 2; ++j) {
        u32x4 o;
#define Q4(b_) (((unsigned)(int)rintf(f[16 * j + (b_)] * inv) & 0xffu) | (((unsigned)(int)rintf(f[16 * j + (b_) + 1] * inv) & 0xffu) << 8) | (((unsigned)(int)rintf(f[16 * j + (b_) + 2] * inv) & 0xffu) << 16) | (((unsigned)(int)rintf(f[16 * j + (b_) + 3] * inv) & 0xffu) << 24))
        o.x = Q4(0); o.y = Q4(4); o.z = Q4(8); o.w = Q4(12);
#undef Q4
        *(u32x4*)(dst + 1024 * j + 16 * lane) = o;
    }
}

__device__ __forceinline__ void p0_wblock_lds(const Ctx& C, const float* __restrict__ W, const float* __restrict__ g, int N, int nb, unsigned char* __restrict__ W8, float* __restrict__ SW) {
    constexpr int PITCH = 4104;
    LAS unsigned char* img = C.lds;
    const int lane = C.lane, nl = 4 * (lane & 7), n = 32 * nb + nl, kq = lane >> 3;
#pragma unroll 1
    for (int i4 = 0; i4 < 4; ++i4) {
        const int k0 = 64 * (4 * C.wave + i4);
        f32x4 v[8];
#pragma unroll
        for (int i = 0; i < 8; ++i) {
            const int kk = k0 + 8 * i + kq;
            v[i] = (n < N) ? *(const f32x4*)(W + (size_t)kk * N + n) : (f32x4){0.f, 0.f, 0.f, 0.f};
            if (g) v[i] = v[i] * g[kk];
        }
#pragma unroll
        for (int i = 0; i < 8; ++i) {
            LAS unsigned short* d = (LAS unsigned short*)(img + nl * PITCH + 2 * (k0 + 8 * i + kq));
            d[0] = (unsigned short)f2bf(v[i].x); d[PITCH / 2] = (unsigned short)f2bf(v[i].y); d[2 * (PITCH / 2)] = (unsigned short)f2bf(v[i].z); d[3 * (PITCH / 2)] = (unsigned short)f2bf(v[i].w);
        }
    }
    __syncthreads();
#pragma unroll 1
    for (int r = 0; r < 4; ++r) {
        const int row = 4 * C.wave + r;
        float f[32]; float mx = 0.f;
#pragma unroll
        for (int j = 0; j < 2; ++j)
#pragma unroll
            for (int q = 0; q < 4; ++q) {
                const u32x2 w = *(const LAS u32x2*)(img + row * PITCH + 2 * (1024 * j + 16 * lane) + 8 * q);
                f[16 * j + 4 * q] = __uint_as_float(w.x << 16); f[16 * j + 4 * q + 1] = __uint_as_float(w.x & 0xffff0000u);
                f[16 * j + 4 * q + 2] = __uint_as_float(w.y << 16); f[16 * j + 4 * q + 3] = __uint_as_float(w.y & 0xffff0000u);
            }
#pragma unroll
        for (int i = 0; i < 32; ++i) mx = fmaxf(mx, fabsf(f[i]));
#pragma unroll
        for (int o = 1; o < 64; o <<= 1) mx = fmaxf(mx, __shfl_xor(mx, o));
        const float inv = mx > 0.f ? 127.0f / mx : 0.f;
        const int nrow = 32 * nb + row;
        if (lane == 0) SW[nrow] = mx * (1.0f / 127.0f);
#pragma unroll
        for (int j = 0; j < 2; ++j) {
            u32x4 o;
#define Q4(b_) (((unsigned)(int)rintf(f[16 * j + (b_)] * inv) & 0xffu) | (((unsigned)(int)rintf(f[16 * j + (b_) + 1] * inv) & 0xffu) << 8) | (((unsigned)(int)rintf(f[16 * j + (b_) + 2] * inv) & 0xffu) << 16) | (((unsigned)(int)rintf(f[16 * j + (b_) + 3] * inv) & 0xffu) << 24))
            o.x = Q4(0); o.y = Q4(4); o.z = Q4(8); o.w = Q4(12);
#undef Q4
            *(u32x4*)(W8 + (size_t)nrow * D + 1024 * j + 16 * lane) = o;
        }
    }
    __syncthreads();
}

__device__ __forceinline__ void p0_wblock_lds_bf16(const Ctx& C, const float* __restrict__ W, int K, int N, int nb, bf16_t* __restrict__ WT) {
    constexpr int PITCH = 4104;
    LAS unsigned char* img = C.lds;
    const int lane = C.lane, nl = 4 * (lane & 7), n = 32 * nb + nl, kq = lane >> 3;
    const int nslab = K / 64;
#pragma unroll 1
    for (int sl = C.wave; sl < nslab; sl += NWAVES) {
        const int k0 = 64 * sl;
        f32x4 v[8];
#pragma unroll
        for (int i = 0; i < 8; ++i) v[i] = (n < N) ? *(const f32x4*)(W + (size_t)(k0 + 8 * i + kq) * N + n) : (f32x4){0.f, 0.f, 0.f, 0.f};
#pragma unroll
        for (int i = 0; i < 8; ++i) {
            LAS unsigned short* d = (LAS unsigned short*)(img + nl * PITCH + 2 * (k0 + 8 * i + kq));
            d[0] = (unsigned short)f2bf(v[i].x); d[PITCH / 2] = (unsigned short)f2bf(v[i].y); d[2 * (PITCH / 2)] = (unsigned short)f2bf(v[i].z); d[3 * (PITCH / 2)] = (unsigned short)f2bf(v[i].w);
        }
    }
    __syncthreads();
    const int ppr = K / 8;
    for (int pc = C.tid; pc < 32 * ppr; pc += NTHR) {
        const int row = pc / ppr, c = pc % ppr;
        const u32x2 lo = *(const LAS u32x2*)(img + row * PITCH + 16 * c), hi = *(const LAS u32x2*)(img + row * PITCH + 16 * c + 8);
        u32x4 o; o.x = lo.x; o.y = lo.y; o.z = hi.x; o.w = hi.y;
        *(u32x4*)((unsigned char*)(WT + (size_t)(32 * nb + row) * K) + 16 * c) = o;
    }
    __syncthreads();
}

__device__ __forceinline__ void p0_prologue(const Ctx& C, const Args& a) {
    unsigned char* ws = a.ws;
    const int gw = C.vcu * NWAVES + C.wave, NGW = C.G * NWAVES;
    const int gt = C.vcu * NTHR + C.tid, NGT = C.G * NTHR;
    for (int nb = C.vcu; nb < NPAD / 32; nb += C.G) p0_wblock_lds(C, a.in[4], a.in[3], NPROJ, nb, ws + WS_W8IN, (float*)(ws + WS_SWIN));
    {
        const float* x = a.in[0]; bf16_t* xb = (bf16_t*)(ws + WS_XB); float* rs1 = (float*)(ws + WS_RS1);
        for (int m = gw; m < T; m += NGW) {
            const f32x4* xr = (const f32x4*)(x + (size_t)m * D) + C.lane;
            f32x4 v[8]; float s = 0.f;
#pragma unroll
            for (int j = 0; j < 8; ++j) { v[j] = xr[64 * j]; s += (v[j].x * v[j].x + v[j].y * v[j].y) + (v[j].z * v[j].z + v[j].w * v[j].w); }
            s = wave_sum(s);
            float mx = 0.f;
#pragma unroll
            for (int j = 0; j < 8; ++j) mx = fmaxf(fmaxf(mx, fmaxf(fabsf(v[j].x), fabsf(v[j].y))), fmaxf(fabsf(v[j].z), fabsf(v[j].w)));
#pragma unroll
            for (int o = 1; o < 64; o <<= 1) mx = fmaxf(mx, __shfl_xor(mx, o));
            const float inv = mx > 0.f ? 127.0f / mx : 0.f;
            if (C.lane == 0) rs1[m] = rsqrtf(s * (1.0f / D) + EPS) * (mx * (1.0f / 127.0f));
            {
                unsigned* q8 = (unsigned*)(ws + WS_X8IN + (size_t)m * D) + C.lane;
#pragma unroll
                for (int j = 0; j < 8; ++j)
                    q8[64 * j] = ((unsigned)(int)rintf(v[j].x * inv) & 0xffu) | (((unsigned)(int)rintf(v[j].y * inv) & 0xffu) << 8) | (((unsigned)(int)rintf(v[j].z * inv) & 0xffu) << 16) | (((unsigned)(int)rintf(v[j].w * inv) & 0xffu) << 24);
            }
            u32x2* o8 = (u32x2*)(xb + (size_t)m * D) + C.lane;
#pragma unroll
            for (int j = 0; j < 8; ++j) { u32x2 w; w.x = pk2(v[j].x, v[j].y); w.y = pk2(v[j].z, v[j].w); o8[64 * j] = w; }
        }
    }
    {
        const int* pos = (const int*)a.in[2]; f32x2* rope = (f32x2*)(ws + WS_ROPE);
        for (int i = gt; i < T * 24; i += NGT) {
            const int t = i / 24, k = i % 24;
            const double fr = (k < 16) ? (double)k / 16.0 : (double)(k - 16) / 8.0;
            const double ang = (double)pos[t] * exp(-13.122363377404328 * fr);
            f32x2 cs; cs.x = (float)cos(ang); cs.y = (float)sin(ang);
            rope[i] = cs;
        }
    }
}

constexpr int DT_TR = 2 * (D / 32);
constexpr int DT_WG = 2 * (D / 32);
constexpr int DT_UV = 2 * PK * PK / 32;
constexpr int DT_P = 64;
constexpr int DT_N = DT_TR + DT_WG + DT_UV + DT_P + 1;
__device__ __forceinline__ void p0_task(const Ctx& C, const Args& a, int task) {
    unsigned char* ws = a.ws;
    if (task < DT_TR) {
        if (task < D / 32) p0_wblock_lds_bf16(C, a.in[8], D, D, task, (bf16_t*)(ws + WS_WOUT));
        else p0_wblock_lds_bf16(C, a.in[16], PLE, D, task - D / 32, (bf16_t*)(ws + WS_WP));
        return;
    }
    task -= DT_TR;
    if (task < DT_WG) {
        const bool isg = task >= D / 32; const int nb = isg ? task - D / 32 : task;
        p0_wblock_lds(C, isg ? a.in[15] : a.in[10], isg ? a.in[14] : nullptr, D, nb, ws + (isg ? WS_WG8 : WS_WPQ8), (float*)(ws + (isg ? WS_SWG : WS_SWPQ)));
        return;
    }
    task -= DT_WG;
    if (task < DT_UV) {
#pragma unroll 1
        for (int jr = 0; jr < 4; ++jr) {
            const int rowg = task * 32 + C.wave * 4 + jr, tsel = rowg >= PK * PK ? 1 : 0, row = rowg - tsel * PK * PK;
            const float* src = tsel ? a.in[13] : a.in[12]; unsigned char* dst = ws + (tsel ? WS_VB : WS_UB); float* scl = (float*)(ws + WS_SCL) + tsel * (PK * PK);
            const float* r = src + (size_t)row * D + C.lane * 16;
            f32x4 v[8]; float m = 0.f;
#pragma unroll
            for (int j = 0; j < 2; ++j)
#pragma unroll
                for (int q = 0; q < 4; ++q) { const f32x4 t4 = *(const f32x4*)(r + 1024 * j + 4 * q); v[4 * j + q] = t4;
                    m = fmaxf(fmaxf(m, fmaxf(fabsf(t4.x), fabsf(t4.y))), fmaxf(fabsf(t4.z), fabsf(t4.w))); }
#pragma unroll
            for (int o = 1; o < 64; o <<= 1) m = fmaxf(m, __shfl_xor(m, o));
            const float inv = m > 0.f ? 127.0f / m : 0.f;
            if (C.lane == 0) scl[row] = m * (1.0f / 127.0f);
#pragma unroll
            for (int j = 0; j < 2; ++j) {
                u32x4 w;
#define Q8(t4) (((unsigned)(int)rintf((t4).x * inv) & 0xffu) | (((unsigned)(int)rintf((t4).y * inv) & 0xffu) << 8) | (((unsigned)(int)rintf((t4).z * inv) & 0xffu) << 16) | (((unsigned)(int)rintf((t4).w * inv) & 0xffu) << 24))
                w.x = Q8(v[4 * j + 0]); w.y = Q8(v[4 * j + 1]); w.z = Q8(v[4 * j + 2]); w.w = Q8(v[4 * j + 3]);
#undef Q8
                if (tsel) *(u32x4*)(dst + (size_t)(4 * j + (C.lane >> 4)) * ((size_t)PK * PK * 256) + (size_t)row * 256 + (C.lane & 15) * 16) = w;
                else *(u32x4*)(dst + (size_t)row * D + C.lane * 16 + 1024 * j) = w;
            }
        }
        return;
    }
    task -= DT_UV;
    const bool is_p = task < DT_P;
    const f32x4* src = (const f32x4*)(is_p ? a.in[1] : a.in[11]); u32x4* dst = (u32x4*)(ws + (is_p ? WS_PB : WS_SUBK));
    const size_t base = is_p ? (size_t)task * 4096 : 0;
#pragma unroll 2
    for (int i = C.tid; i < 4096; i += NTHR) {
        const f32x4 a0 = src[2 * (base + i)], a1 = src[2 * (base + i) + 1];
        u32x4 w; w.x = pk2(a0.x, a0.y); w.y = pk2(a0.z, a0.w); w.z = pk2(a1.x, a1.y); w.w = pk2(a1.z, a1.w);
        dst[base + i] = w;
    }
}
__device__ __forceinline__ void st_wt(void* p, u32x2 v) {
    __hip_atomic_store((unsigned long long*)p, (unsigned long long)v.x | ((unsigned long long)v.y << 32), __ATOMIC_RELAXED, __HIP_MEMORY_SCOPE_AGENT);
}
constexpr int P1_IDX_TILES = 5 * (T / 256);
struct InProjOrder {
    pg8::StaticOrder so; unsigned* done_cnt;
    __device__ __forceinline__ bool next(int i, pg8::Unit& u) const {
        if (!so.next(i, u)) return false;
        const int p = u.pn; u.pn = (p < 3) ? 24 + p : (p < 15) ? p - 3 : (p < 17) ? 12 + p : p - 5; return true;
    }
    __device__ __forceinline__ void a_ready(const pg8::Unit&) const {}
    __device__ __forceinline__ void done(const pg8::Unit& u) const {
        if (u.pn >= 24) {
            asm volatile("s_waitcnt vmcnt(0)" ::: "memory");
            __builtin_amdgcn_s_barrier();
            if (threadIdx.x == 0) __hip_atomic_fetch_add(done_cnt, 1u, __ATOMIC_RELAXED, __HIP_MEMORY_SCOPE_AGENT);
        }
    }
};
struct EpiInProj {
    static constexpr bool PERM = false, AFTER_DRAIN = false;
    const float* rs1; const float* sw; const f32x2* rope; const float* gqa; const float* gqb;
    bf16_t *QKV0, *QI, *KI; float* WI;
    LAS float* scr;
    __device__ __forceinline__ void operator()(const pg8::i32x4 (&acci)[2][2][4][2], const pg8::Unit& u, int wr, int wc, int fr, int fq) const {
        const int pn = u.pn;
        f32x4 swv[2][2];
#pragma unroll
        for (int bj = 0; bj < 2; ++bj)
#pragma unroll
            for (int n = 0; n < 2; ++n) swv[bj][n] = *(const f32x4*)(sw + pn * 256 + bj * 128 + 32 * wc + 16 * n + 4 * fq);
#define ACCF(ai, bj, m, n) (__builtin_convertvector(acci[ai][bj][m][n], f32x4) * swv[bj][n])
        const int row0 = u.pm * 256 + wr * 64 + fr, rl0 = wr * 64 + fr;
        if (pn < 24) {
            const int grp = pn >> 2;
            const bool norm = (grp != 2 && grp != 5), rope_on = (grp == 3 || grp == 4);
            bf16_t* dst = QKV0 + (size_t)grp * (size_t)(8u << 20);
            const int colbase = (pn & 3) * 256 + 32 * wc + 4 * fq;
            f32x4 gv[2] = {(f32x4){1.f, 1.f, 1.f, 1.f}, (f32x4){1.f, 1.f, 1.f, 1.f}};
            if (norm) {
#pragma unroll
                for (int ai = 0; ai < 2; ++ai)
#pragma unroll
                    for (int m = 0; m < 4; ++m)
#pragma unroll
                        for (int bj = 0; bj < 2; ++bj) {
                            const f32x4 a0 = ACCF(ai, bj, m, 0), a1 = ACCF(ai, bj, m, 1);
                            float s = (a0.x * a0.x + a0.y * a0.y) + (a0.z * a0.z + a0.w * a0.w) + (a1.x * a1.x + a1.y * a1.y) + (a1.z * a1.z + a1.w * a1.w);
                            s += __shfl_xor(s, 16); s += __shfl_xor(s, 32);
                            if (fq == 0) scr[((ai * 128 + rl0 + m * 16) * 2 + bj) * 4 + wc] = s;
                        }
                const float* g = ((grp < 2) ? gqa : gqb) + ((grp == 1 || grp == 4) ? 128 : 0);
                gv[0] = *(const f32x4*)(g + 32 * wc + 4 * fq); gv[1] = *(const f32x4*)(g + 32 * wc + 16 + 4 * fq);
                asm volatile("s_waitcnt lgkmcnt(0)" ::: "memory"); __builtin_amdgcn_s_barrier(); asm volatile("" ::: "memory");
            }
#pragma unroll
            for (int ai = 0; ai < 2; ++ai)
#pragma unroll
                for (int m = 0; m < 4; ++m) {
                    const int row = row0 + ai * 128 + m * 16;
                    const float r = rs1[row];
                    f32x4 cs0 = (f32x4){1.f, 0.f, 1.f, 0.f}, cs1 = cs0;
                    if (rope_on && wc == 0) { const f32x4* rp = (const f32x4*)(rope + (size_t)row * 24 + 4 * fq); cs0 = rp[0]; cs1 = rp[1]; }
#pragma unroll
                    for (int bj = 0; bj < 2; ++bj) {
                        float sc = r;
                        if (norm) {
                            const f32x4 p4 = *(const LAS f32x4*)&scr[((ai * 128 + rl0 + m * 16) * 2 + bj) * 4];
                            const float tot = (p4.x + p4.y) + (p4.z + p4.w);
                            sc = r * rsqrtf(r * r * tot * (1.0f / 128.f) + EPS);
                        }
                        f32x4 y0 = ACCF(ai, bj, m, 0) * sc * gv[0], y1 = ACCF(ai, bj, m, 1) * sc * gv[1];
                        if (rope_on && wc == 0) {
                            const f32x4 x1 = y0, x2 = y1;
                            y0.x = x1.x * cs0.x - x2.x * cs0.y; y1.x = x2.x * cs0.x + x1.x * cs0.y;
                            y0.y = x1.y * cs0.z - x2.y * cs0.w; y1.y = x2.y * cs0.z + x1.y * cs0.w;
                            y0.z = x1.z * cs1.x - x2.z * cs1.y; y1.z = x2.z * cs1.x + x1.z * cs1.y;
                            y0.w = x1.w * cs1.z - x2.w * cs1.w; y1.w = x2.w * cs1.z + x1.w * cs1.w;
                        }
                        bf16_t* dp = dst + (size_t)row * 1024 + colbase + bj * 128;
                        u32x2 w0, w1; w0.x = pk2(y0.x, y0.y); w0.y = pk2(y0.z, y0.w); w1.x = pk2(y1.x, y1.y); w1.y = pk2(y1.z, y1.w);
                        *(u32x2*)dp = w0; *(u32x2*)(dp + 16) = w1;
                    }
                }
        } else {
            const bool is_qi = pn < 28;
#pragma unroll
            for (int ai = 0; ai < 2; ++ai)
#pragma unroll
                for (int m = 0; m < 4; ++m) {
                    const int row = row0 + ai * 128 + m * 16;
                    const float r = rs1[row];
                    f32x4 cs0 = (f32x4){1.f, 0.f, 1.f, 0.f}, cs1 = cs0;
                    if ((wc & 1) == 0) { const f32x4* rp = (const f32x4*)(rope + (size_t)row * 24 + 16 + 4 * (fq & 1)); cs0 = rp[0]; cs1 = rp[1]; }
#pragma unroll
                    for (int bj = 0; bj < 2; ++bj) {
                        if (!is_qi && bj == 1) continue;
                        f32x4 y0 = ACCF(ai, bj, m, 0) * r, y1 = ACCF(ai, bj, m, 1) * r;
                        if ((wc & 1) == 0 && (is_qi || wc == 0)) {
                            f32x4 pt; pt.x = __shfl_xor(y0.x, 32); pt.y = __shfl_xor(y0.y, 32); pt.z = __shfl_xor(y0.z, 32); pt.w = __shfl_xor(y0.w, 32);
                            const float sg = (fq < 2) ? -1.f : 1.f;
                            y0.x = y0.x * cs0.x + sg * pt.x * cs0.y; y0.y = y0.y * cs0.z + sg * pt.y * cs0.w;
                            y0.z = y0.z * cs1.x + sg * pt.z * cs1.y; y0.w = y0.w * cs1.z + sg * pt.w * cs1.w;
                        }
                        if (is_qi) {
                            bf16_t* dp = QI + (size_t)row * 1024 + (pn - 24) * 256 + bj * 128 + 32 * wc + 4 * fq;
                            u32x2 w0, w1; w0.x = pk2(y0.x, y0.y); w0.y = pk2(y0.z, y0.w); w1.x = pk2(y1.x, y1.y); w1.y = pk2(y1.z, y1.w);
                            st_wt(dp, w0); st_wt(dp + 16, w1);
                        } else if (wc < 2) {
                            bf16_t* dp = KI + (size_t)row * 64 + 32 * wc + 4 * fq;
                            u32x2 w0, w1; w0.x = pk2(y0.x, y0.y); w0.y = pk2(y0.z, y0.w); w1.x = pk2(y1.x, y1.y); w1.y = pk2(y1.z, y1.w);
                            st_wt(dp, w0); st_wt(dp + 16, w1);
                        } else if (wc == 2) {
                            const f32x4 wv = y0 * 0.03125f; float* wp_ = WI + (size_t)row * 16 + 4 * fq;
                            u32x2 w0, w1; w0.x = __float_as_uint(wv.x); w0.y = __float_as_uint(wv.y); w1.x = __float_as_uint(wv.z); w1.y = __float_as_uint(wv.w);
                            st_wt(wp_, w0); st_wt(wp_ + 2, w1);
                        }
                    }
                }
        }
    }
#undef ACCF
};

__device__ __forceinline__ void p1_inproj(const Ctx& C, const Args& a) {
    unsigned char* ws = a.ws;
    pg8::Gemm g{(const bf16_t*)(ws + WS_X8IN), (const bf16_t*)(ws + WS_W8IN), T, NPAD, D / 2};
    InProjOrder S; S.so.init(T, NPAD, C.G, C.bid); S.done_cnt = (unsigned*)(ws + WS_QCNT) + 64 * 18;
    EpiInProj E{(const float*)(ws + WS_RS1), (const float*)(ws + WS_SWIN), (const f32x2*)(ws + WS_ROPE), a.in[5], a.in[6],
                (bf16_t*)(ws + WS_QA),
                (bf16_t*)(ws + WS_QI), (bf16_t*)(ws + WS_KI), (float*)(ws + WS_WI), (LAS float*)(C.lds + EPI_OFF)};
    pg8::gemm_phase<EpiInProj, InProjOrder, true, true, true>(C.lds, g, S, E);
}
namespace at {
constexpr float SCALE = 0.08838834764831845f;
constexpr int NW = 8, QBLK = 32, KVBLK = 64, QB = NW * QBLK, DH = 128;
constexpr int PQ = 1024;
constexpr int PO = 2048;
constexpr int SHM_V = KVBLK * DH * 2, SHM_K = KVBLK * DH * 2;
constexpr int OFF_WS = 2 * SHM_V + 2 * SHM_K;
constexpr int OFF_BIAS = OFF_WS + NW * 64 * 4;
constexpr int OFF_Q = OFF_BIAS + 264 * 4;
constexpr int LDS_ATT = OFF_Q + NW * 8192;
constexpr float THR = 8.f;
#define KSWZ(row, colB) ((row) * 256 + ((colB) ^ (((row) & 7) << 4)))
#define SBAR() __builtin_amdgcn_sched_barrier(0)
__device__ __forceinline__ int v_st(int k, int c) { const int kk = (k & ~0xC) | ((k & 4) << 1) | ((k & 8) >> 1); return ((kk >> 3) * 4 + (c >> 5)) * 512 + ((kk & 7) * 32 + (c & 31)) * 2; }
__device__ __forceinline__ int v_rd_base(int lane) { return ((lane & 3) << 3) | (((lane >> 2) & 3) << 6) | (((lane >> 4) & 1) << 5) | (((lane >> 5) & 1) << 8); }
constexpr int v_rd_off(int d0, int ks, int half) { return d0 * 512 + ks * 4096 + half * 2048; }
__device__ __forceinline__ int crow(int r, int hi) { return (r & 3) + 8 * (r >> 2) + 4 * hi; }
__device__ __forceinline__ unsigned cvtpk(float lo, float hi) { unsigned r; asm volatile("v_cvt_pk_bf16_f32 %0, %1, %2" : "=v"(r) : "v"(lo), "v"(hi)); return r; }

__device__ __forceinline__ void partialSM(f32x16& p0, f32x16& p1, float& m_reg, float& mn, float& alpha) {
    constexpr float C2 = 1.4426950408889634f * SCALE;
    mn = m_reg; alpha = 1.f;
    const float mnL = -m_reg * C2;
#pragma unroll
    for (int r = 0; r < 16; ++r) p0[r] = fmaf(p0[r], C2, mnL);
#pragma unroll
    for (int r = 0; r < 16; ++r) p1[r] = fmaf(p1[r], C2, mnL);
#pragma unroll
    for (int r = 0; r < 16; ++r) p0[r] = __builtin_amdgcn_exp2f(p0[r]);
}
__device__ __forceinline__ void finishSM(f32x16& p0, f32x16& p1, float alpha, float& l_reg, bf16x8& pa0, bf16x8& pa1, bf16x8& pa2, bf16x8& pa3) {
#pragma unroll
    for (int r = 0; r < 16; ++r) p1[r] = __builtin_amdgcn_exp2f(p1[r]);
    float ps = 0;
#pragma unroll
    for (int r = 0; r < 16; ++r) ps += p0[r];
#pragma unroll
    for (int r = 0; r < 16; ++r) ps += p1[r];
    { auto rr = __builtin_amdgcn_permlane32_swap(__float_as_uint(ps), __float_as_uint(ps), false, false);
      ps = __uint_as_float(rr[0]) + __uint_as_float(rr[1]); }
    l_reg = l_reg * alpha + ps;
#define PK4(P, B_, OUT) do { unsigned a0 = cvtpk(P[B_+0], P[B_+1]), a1 = cvtpk(P[B_+2], P[B_+3]);                          \
        unsigned b0 = cvtpk(P[B_+4], P[B_+5]), b1 = cvtpk(P[B_+6], P[B_+7]);                                             \
        auto r0 = __builtin_amdgcn_permlane32_swap(a0, b0, false, false); auto r1 = __builtin_amdgcn_permlane32_swap(a1, b1, false, false); \
        u32x4 w = {r0[0], r1[0], r0[1], r1[1]}; OUT = *reinterpret_cast<bf16x8*>(&w); } while (0)
    PK4(p0, 0, pa0); PK4(p0, 8, pa1); PK4(p1, 0, pa2); PK4(p1, 8, pa3);
#undef PK4
}
template <int KB>
__device__ __forceinline__ void qkt(f32x16& p0, f32x16& p1, const char* K_lds, int r32, int hi, const char* qw, bool act) {
    if (!act) { const float NEG = -__builtin_inff();
#pragma unroll
        for (int r = 0; r < 16; ++r) { p0[r] = NEG; p1[r] = NEG; } return; }
    p0 = f32x16{}; p1 = f32x16{};
    const char* kb[4];
#pragma unroll
    for (int dd = 0; dd < 4; ++dd) kb[dd] = K_lds + KB * SHM_K + KSWZ(r32, (dd * 16 + hi * 8) * 2);
#pragma unroll
    for (int d0 = 0; d0 < 8; ++d0) { const char* a = kb[d0 & 3] + (d0 >> 2) * 128;
        bf16x8 b0 = *reinterpret_cast<const bf16x8*>(a);
        bf16x8 b1 = *reinterpret_cast<const bf16x8*>(a + 32 * 256);
        const bf16x8 qf = *reinterpret_cast<const bf16x8*>(qw + d0 * 1024);
        p0 = __builtin_amdgcn_mfma_f32_32x32x16_bf16(b0, qf, p0, 0, 0, 0);
        p1 = __builtin_amdgcn_mfma_f32_32x32x16_bf16(b1, qf, p1, 0, 0, 0); }
}
template <int VB>
__device__ __forceinline__ void pv_tile(f32x16* o, int vb0, bf16x8 pa0, bf16x8 pa1, bf16x8 pa2, bf16x8 pa3, bool act) {
    if (!act) return;
#define TRRD(dst, off) asm volatile("ds_read_b64_tr_b16 %0, %1 offset:%2" : "=&v"(dst) : "v"(vb0), "i"(off) : "memory")
#define PV_D0(d0) do { s16x4 l0, l1, l2, l3, h0, h1, h2, h3; constexpr int b_ = VB * SHM_V + v_rd_off(d0, 0, 0); \
        TRRD(l0, b_); TRRD(h0, b_ + 2048); TRRD(l1, b_ + 4096); TRRD(h1, b_ + 6144); TRRD(l2, b_ + 8192); TRRD(h2, b_ + 10240); TRRD(l3, b_ + 12288); TRRD(h3, b_ + 14336); \
        asm volatile("s_waitcnt lgkmcnt(0)" ::: "memory"); SBAR();   \
        o[d0] = __builtin_amdgcn_mfma_f32_32x32x16_bf16(pa0, (bf16x8){l0[0], l0[1], l0[2], l0[3], h0[0], h0[1], h0[2], h0[3]}, o[d0], 0, 0, 0);   \
        o[d0] = __builtin_amdgcn_mfma_f32_32x32x16_bf16(pa1, (bf16x8){l1[0], l1[1], l1[2], l1[3], h1[0], h1[1], h1[2], h1[3]}, o[d0], 0, 0, 0);   \
        o[d0] = __builtin_amdgcn_mfma_f32_32x32x16_bf16(pa2, (bf16x8){l2[0], l2[1], l2[2], l2[3], h2[0], h2[1], h2[2], h2[3]}, o[d0], 0, 0, 0);   \
        o[d0] = __builtin_amdgcn_mfma_f32_32x32x16_bf16(pa3, (bf16x8){l3[0], l3[1], l3[2], l3[3], h3[0], h3[1], h3[2], h3[3]}, o[d0], 0, 0, 0); } while (0)
    PV_D0(0); PV_D0(1); PV_D0(2); PV_D0(3);
#undef PV_D0
#undef TRRD
}

struct BlockRef { const bf16_t* Q; const bf16_t* K; const bf16_t* V; bf16_t* O; int qb; const float* gains;   const unsigned long long* bm;   const float* bias;   };
struct Seam { bf16x8 st_v0, st_v1, st_k0, st_k1; };

template <int MODE> __device__ __forceinline__ int blk_jlo(int qb) { return MODE == 0 ? (4 * qb - 8 > 0 ? 4 * qb - 8 : 0) : 0; }

#define ROW(p, k0, rr) ((p) + (size_t)((k0) + (rr)) * PQ + sc)
#define VMW() asm volatile("s_waitcnt vmcnt(0)" ::: "memory")
#define VMWN(n) asm volatile("s_waitcnt vmcnt(%0)" :: "i"(n) : "memory")
#define LD8(p) (*reinterpret_cast<const bf16x8*>(p))
#define SLOAD_H(Kp, Vp, k0) do { S.st_v0 = LD8(ROW(Vp, k0, sr)); S.st_v1 = LD8(ROW(Vp, k0, 32 + sr)); S.st_k0 = LD8(ROW(Kp, k0, sr)); S.st_k1 = LD8(ROW(Kp, k0, 32 + sr)); } while (0)
#define SWRITE_HK(bf) do { *(bf16x8*)(K_lds + (bf) * SHM_K + kws) = S.st_k0; *(bf16x8*)(K_lds + (bf) * SHM_K + kws + 32 * 256) = S.st_k1; } while (0)
#define SWRITE_HV(bf) do { *(bf16x8*)(V_lds + (bf) * SHM_V + vst0) = S.st_v0; *(bf16x8*)(V_lds + (bf) * SHM_V + vst1) = S.st_v1; } while (0)
#define SWRITE_H(bf) do { SWRITE_HV(bf); SWRITE_HK(bf); } while (0)

template <int MODE>
__device__ __forceinline__ void attn_prime(const BlockRef& cur, char* lds, Seam& S) {
    int tid_ = threadIdx.x; asm volatile("" : "+v"(tid_));
    const int tid = tid_, wid = __builtin_amdgcn_readfirstlane(tid >> 6), lane = tid & 63, r32 = lane & 31, hi = lane >> 5;
    const int sr = tid >> 4, sc = (tid & 15) * 8, kws = KSWZ(sr, sc * 2); char* K_lds = lds + 2 * SHM_V;
    const int kb0 = blk_jlo<MODE>(cur.qb) * KVBLK;
    (void)wid; (void)lane; (void)r32; (void)hi;
    SLOAD_H(cur.K, cur.V, kb0); VMW(); SWRITE_HK(0);
    __syncthreads();
}

template <int MODE>
__device__ __forceinline__ void attn_block(const BlockRef& cur, const BlockRef& nxt, char* lds, Seam& S) {
    int tid_ = threadIdx.x; asm volatile("" : "+v"(tid_));
    const int tid = tid_, wid = __builtin_amdgcn_readfirstlane(tid >> 6), lane = tid & 63, r32 = lane & 31, hi = lane >> 5;
    const int P0 = cur.qb * QB;
    const int j_lo = blk_jlo<MODE>(cur.qb), j_hi = 4 * cur.qb + 4;
    const int NT = j_hi - j_lo;
    const int kbn = blk_jlo<MODE>(nxt.qb) * KVBLK;
    const int qlo = P0 + wid * QBLK;
    const int cw = qlo >> 6;
    char* V_lds = lds; char* K_lds = lds + 2 * SHM_V;
    float* ws = (float*)(lds + OFF_WS) + wid * 64; float* li_l = ws, * al_l = ws + 32;
    float* btab = (float*)(lds + OFF_BIAS);
    float m_reg = 0.f, l_reg = 0; f32x16 o[4] = {};
    const int sr = tid >> 4, sc = (tid & 15) * 8, vst0 = v_st(sr, sc), vst1 = v_st(32 + sr, sc), kws = KSWZ(sr, sc * 2);
    const int vb0 = (int)(uintptr_t)V_lds + v_rd_base(lane);
    const bf16_t* Kh = cur.K; const bf16_t* Vh = cur.V;
    char* qw = lds + OFF_Q + wid * 8192 + lane * 16;
    {
        bf16x8 qt[8];
#pragma unroll
        for (int d0 = 0; d0 < 8; ++d0) qt[d0] = LD8(cur.Q + (size_t)(wid * QBLK + r32) * PQ + d0 * 16 + hi * 8);
#pragma unroll
        for (int d0 = 0; d0 < 8; ++d0) *reinterpret_cast<bf16x8*>(qw + d0 * 1024) = qt[d0];
    }
    if (MODE == 0) {
        if (tid < 257) btab[tid] = cur.bias[tid] * (1.0f / SCALE);
        __syncthreads();
    }
    {
        float gq = fmaxf(fabsf(cur.gains[lane]), fabsf(cur.gains[lane + 64])), gk = fmaxf(fabsf(cur.gains[128 + lane]), fabsf(cur.gains[192 + lane]));
        float bb = 0.f;
        if (MODE == 0) { for (int i = lane; i < 257; i += 64) bb = fmaxf(bb, fabsf(btab[i])); }
#pragma unroll
        for (int o_ = 1; o_ < 64; o_ <<= 1) { gq = fmaxf(gq, __shfl_xor(gq, o_)); gk = fmaxf(gk, __shfl_xor(gk, o_)); bb = fmaxf(bb, __shfl_xor(bb, o_)); }
        m_reg = (128.f * gq * gk + bb) * 1.01f;
    }
    const unsigned long long* bmrow = (MODE == 1) ? cur.bm + (size_t)(wid * QBLK + r32) * 64 : nullptr;
#define RESC(a) do { } while (0)
#define JC(t) (j_lo + (t))
#define KBASE(t) (JC(t) * KVBLK)
#define ACT(t) (MODE == 0 ? (JC(t) >= cw - 8 && JC(t) <= cw) : (JC(t) <= cw))
#define MODT(P0_, P1_, t) do { if (ACT(t)) { const int kb_ = KBASE(t);                                                                   \
        if (MODE == 0) {                                                                                                                   \
            if (kb_ + KVBLK - 1 + 128 <= qlo) { const float cb = btab[256];                                                               \
                _Pragma("unroll") for (int r = 0; r < 16; ++r) { P0_[r] += cb; P1_[r] += cb; } }                                          \
            else { int dq = qlo + r32 - kb_ - 4 * hi + 128; asm volatile("" : "+v"(dq));                                                  \
                _Pragma("unroll") for (int r = 0; r < 16; ++r) { const int c = (r & 3) + 8 * (r >> 2);                                     \
                    int i0 = dq - c, i1 = dq - c - 32; i0 = i0 < 0 ? 0 : (i0 > 256 ? 256 : i0); i1 = i1 < 0 ? 0 : (i1 > 256 ? 256 : i1); \
                    P0_[r] += btab[i0]; P1_[r] += btab[i1]; } }                                                                            \
        } else {                                                                                                                           \
            const unsigned long long w_ = mw;                                                                                              \
            unsigned lo_ = (unsigned)w_ >> (4 * hi), hi_ = (unsigned)(w_ >> 32) >> (4 * hi); const float NEG = -__builtin_inff();          \
            asm volatile("" : "+v"(lo_), "+v"(hi_));                                                                                         \
            _Pragma("unroll") for (int r = 0; r < 16; ++r) { const int c = (r & 3) + 8 * (r >> 2);                                         \
                if (!((lo_ >> c) & 1u)) P0_[r] = NEG; if (!((hi_ >> c) & 1u)) P1_[r] = NEG; } }                                            \
    } } while (0)
#define MLOAD(t) do { if (MODE == 1) mw = bmrow[JC(t)]; } while (0)
#define SEAM_K0() do { VMW(); SWRITE_HK(0); SBAR(); } while (0)
    f32x16 pA0, pA1, pB0, pB1; float mnA, mnB, alA, alB; bf16x8 pa0, pa1, pa2, pa3;
    unsigned long long mw = 0;
    SWRITE_HV(0); SBAR();
    if (NT > 1) SLOAD_H(Kh, Vh, KBASE(1));
    MLOAD(0);
    SBAR(); qkt<0>(pA0, pA1, K_lds, r32, hi, qw, ACT(0));
    MODT(pA0, pA1, 0); partialSM(pA0, pA1, m_reg, mnA, alA);
    if (NT > 1) { VMW(); SWRITE_H(1); }
    __syncthreads();
#define HALF_STEP(PX0, PX1, mnX, alX, PY0, PY1, alY, t, KB, VB, SB) do {                                                      \
        MLOAD(t);                                                                                                             \
        SBAR(); qkt<KB>(PX0, PX1, K_lds, r32, hi, qw, ACT(t));                                                              \
        finishSM(PY0, PY1, alY, l_reg, pa0, pa1, pa2, pa3); SBAR();                                                           \
        if ((t) + 1 < NT) { SLOAD_H(Kh, Vh, KBASE((t) + 1)); SBAR(); }                                                        \
        pv_tile<VB>(o, vb0, pa0, pa1, pa2, pa3, ACT((t) - 1)); MODT(PX0, PX1, (t)); partialSM(PX0, PX1, m_reg, mnX, alX);    \
        __syncthreads();                                                                                                      \
        if ((t) + 1 < NT) { VMW(); SWRITE_H(SB); }                                                                            \
        RESC(alX); __syncthreads(); } while (0)
    for (int t = 1; t + 1 < NT; t += 2) {
        HALF_STEP(pB0, pB1, mnB, alB, pA0, pA1, alA, t, 1, 0, 0);
        HALF_STEP(pA0, pA1, mnA, alA, pB0, pB1, alB, t + 1, 0, 1, 1);
    }
    const bool even = (NT & 1) == 0;
    if (even) { MLOAD(NT - 1); SBAR(); qkt<1>(pB0, pB1, K_lds, r32, hi, qw, ACT(NT - 1)); SBAR(); }
    SLOAD_H(nxt.K, nxt.V, kbn); SBAR();
    finishSM(pA0, pA1, alA, l_reg, pa0, pa1, pa2, pa3); SBAR();
    pv_tile<0>(o, vb0, pa0, pa1, pa2, pa3, ACT(even ? NT - 2 : NT - 1));
    if (even) { MODT(pB0, pB1, NT - 1); partialSM(pB0, pB1, m_reg, mnB, alB); __syncthreads(); RESC(alB);
        finishSM(pB0, pB1, alB, l_reg, pa0, pa1, pa2, pa3); SBAR(); pv_tile<1>(o, vb0, pa0, pa1, pa2, pa3, ACT(NT - 1)); }
    SBAR(); SEAM_K0();
    if (hi == 0) li_l[r32] = l_reg; asm volatile("s_waitcnt lgkmcnt(0)" ::: "memory");
    float rli[16];
#pragma unroll
    for (int r = 0; r < 16; ++r) rli[r] = __builtin_amdgcn_rcpf(li_l[crow(r, hi)]);
    bf16_t* Ow = cur.O + (size_t)(wid * QBLK) * PO;
#pragma unroll
    for (int r = 0; r < 16; ++r) { const int orow = crow(r, hi);
#pragma unroll
        for (int d0 = 0; d0 < 4; ++d0) { const float v = o[d0][r] * rli[r];
            const float vn = __shfl_xor(v, 1);
            if ((r32 & 1) == 0) *(unsigned*)(Ow + (size_t)orow * PO + d0 * 32 + r32) = cvtpk(v, vn); } }
    __syncthreads();
#undef RESC
#undef JC
#undef KBASE
#undef ACT
#undef MODT
#undef MLOAD
#undef SEAM_K0
#undef HALF_STEP
}
#undef ROW
#undef VMW
#undef VMWN
#undef LD8
#undef SLOAD_H
#undef SWRITE_HK
#undef SWRITE_HV
#undef SWRITE_H
#undef KSWZ
#undef SBAR
}
struct P2Item { int b, qt, kb; };
__device__ __forceinline__ P2Item p2_item(int L) {
    P2Item it; constexpr int PER_B = 1088;
    it.b = L / PER_B; int rem = L % PER_B; int j = 0; while (rem >= 8 * (j + 1)) { rem -= 8 * (j + 1); ++j; }
    it.qt = 8 * j + rem / (j + 1); it.kb = rem % (j + 1); return it;
}
__device__ __forceinline__ void p2_scores(const Ctx& C, const Args& a) {
    unsigned char* ws = a.ws;
    const bf16_t* QI = (const bf16_t*)(ws + WS_QI); const bf16_t* KI = (const bf16_t*)(ws + WS_KI); const float* WI = (const float*)(ws + WS_WI);
    float* SC = (float*)(ws + WS_SC);
    LAS unsigned char* lds = C.lds;
    constexpr int QB = 65536 + 2048;
    const int tid = C.tid, lane = C.lane, wid = C.wave, r = lane & 31, hh = lane >> 5;
    const int srow = tid >> 4, sc0 = tid & 15;
    constexpr int NITEM = 2 * 1088;
    u32x4 nq[8]; float nw = 0.f;
    int L = C.vcu, buf = 0;
    if (L < NITEM) {
        const P2Item it = p2_item(L); const int q0 = it.b * S + it.qt * 32;
#pragma unroll
        for (int i = 0; i < 8; ++i) nq[i] = *(const u32x4*)(QI + (size_t)(q0 + srow) * 1024 + (sc0 + 16 * i) * 8);
        nw = WI[(size_t)(q0 + srow) * 16 + sc0];
        __syncthreads();
#pragma unroll
        for (int i = 0; i < 8; ++i) { const int ch = sc0 + 16 * i; *(LAS u32x4*)(lds + srow * 2048 + ((ch ^ (srow & 15)) << 4)) = nq[i]; }
        ((LAS float*)(lds + 65536))[sc0 * 32 + srow] = nw;
        __syncthreads();
    }
    for (; L < NITEM; L += C.G) {
        const P2Item it = p2_item(L);
        const int q0 = it.b * S + it.qt * 32, nadm = (it.qt / 2 + 1) * 64, kbase = it.kb * 256 + wid * 32;
        const bool more = L + C.G < NITEM;
        if (more) {
            const P2Item nx = p2_item(L + C.G); const int qn = nx.b * S + nx.qt * 32;
#pragma unroll
            for (int i = 0; i < 8; ++i) nq[i] = *(const u32x4*)(QI + (size_t)(qn + srow) * 1024 + (sc0 + 16 * i) * 8);
            nw = WI[(size_t)(qn + srow) * 16 + sc0];
        }
        const LAS unsigned char* qb = lds + buf * QB;
        if (kbase < nadm) {
            bf16x8 bfrag[4];
#pragma unroll
            for (int ks = 0; ks < 4; ++ks) bfrag[ks] = *(const bf16x8*)(KI + (size_t)(it.b * S + kbase + r) * 64 + ks * 16 + hh * 8);
            f32x16 score = f32x16{};
#pragma unroll 4
            for (int h = 0; h < 16; ++h) {
                f32x16 acc = f32x16{};
#pragma unroll
                for (int ks = 0; ks < 4; ++ks) {
                    const int ch = h * 8 + 2 * ks + hh;
                    const bf16x8 af = *(const LAS bf16x8*)(qb + r * 2048 + ((ch ^ (r & 15)) << 4));
                    acc = __builtin_amdgcn_mfma_f32_32x32x16_bf16(af, bfrag[ks], acc, 0, 0, 0);
                }
                const LAS float* wf = (const LAS float*)(qb + 65536) + h * 32 + 4 * hh;
#pragma unroll
                for (int g = 0; g < 4; ++g) {
                    const f32x4 w4 = *(const LAS f32x4*)(wf + 8 * g);
                    score[4 * g + 0] = fmaf(w4.x, fmaxf(acc[4 * g + 0], 0.f), score[4 * g + 0]);
                    score[4 * g + 1] = fmaf(w4.y, fmaxf(acc[4 * g + 1], 0.f), score[4 * g + 1]);
                    score[4 * g + 2] = fmaf(w4.z, fmaxf(acc[4 * g + 2], 0.f), score[4 * g + 2]);
                    score[4 * g + 3] = fmaf(w4.w, fmaxf(acc[4 * g + 3], 0.f), score[4 * g + 3]);
                }
            }
            float* out = SC + (size_t)q0 * 4096 + kbase + r;
#pragma unroll
            for (int r16 = 0; r16 < 16; ++r16) out[(size_t)((r16 & 3) + 8 * (r16 >> 2) + 4 * hh) * 4096] = score[r16];
        }
        if (more) {
            LAS unsigned char* nb = lds + (buf ^ 1) * QB;
#pragma unroll
            for (int i = 0; i < 8; ++i) { const int ch = sc0 + 16 * i; *(LAS u32x4*)(nb + srow * 2048 + ((ch ^ (srow & 15)) << 4)) = nq[i]; }
            ((LAS float*)(nb + 65536))[sc0 * 32 + srow] = nw;
        }
        __syncthreads();
        buf ^= 1;
    }
}

__device__ __forceinline__ unsigned skey(float f) { const unsigned u = __builtin_bit_cast(unsigned, f); return (u & 0x80000000u) ? ~u : (u | 0x80000000u); }
__device__ __forceinline__ int wave_sum_i_dpp(int x) {
    x += __builtin_amdgcn_update_dpp(0, x, 0xB1, 0xF, 0xF, true);
    x += __builtin_amdgcn_update_dpp(0, x, 0x4E, 0xF, 0xF, true);
    x += __builtin_amdgcn_update_dpp(0, x, 0x141, 0xF, 0xF, true);
    x += __builtin_amdgcn_update_dpp(0, x, 0x140, 0xF, 0xF, true);
    return __builtin_amdgcn_readlane(x, 0) + __builtin_amdgcn_readlane(x, 16) + __builtin_amdgcn_readlane(x, 32) + __builtin_amdgcn_readlane(x, 48);
}
__device__ __forceinline__ float wave_max_f_dpp(float x) {
    x = fmaxf(x, __builtin_bit_cast(float, __builtin_amdgcn_update_dpp(0, __builtin_bit_cast(int, x), 0xB1, 0xF, 0xF, true)));
    x = fmaxf(x, __builtin_bit_cast(float, __builtin_amdgcn_update_dpp(0, __builtin_bit_cast(int, x), 0x4E, 0xF, 0xF, true)));
    x = fmaxf(x, __builtin_bit_cast(float, __builtin_amdgcn_update_dpp(0, __builtin_bit_cast(int, x), 0x141, 0xF, 0xF, true)));
    x = fmaxf(x, __builtin_bit_cast(float, __builtin_amdgcn_update_dpp(0, __builtin_bit_cast(int, x), 0x140, 0xF, 0xF, true)));
    const int xi = __builtin_bit_cast(int, x);
    return fmaxf(fmaxf(__builtin_bit_cast(float, __builtin_amdgcn_readlane(xi, 0)), __builtin_bit_cast(float, __builtin_amdgcn_readlane(xi, 16))),
                 fmaxf(__builtin_bit_cast(float, __builtin_amdgcn_readlane(xi, 32)), __builtin_bit_cast(float, __builtin_amdgcn_readlane(xi, 48))));
}
template <int NR, class SP>
__device__ __forceinline__ void p3_select_row(SP sr, int n64, unsigned long long* __restrict__ bmrow, int lane) {
    float v[NR];
#pragma unroll
    for (int i = 0; i < NR; ++i) v[i] = (i < n64) ? sr[64 * i] : -__builtin_inff();
    float thr = -__builtin_inff();
    if (n64 > TOPK / 64) {
        float mx = v[0], mn = v[0];
#pragma unroll
        for (int i = 1; i < NR; ++i) { mx = fmaxf(mx, v[i]); if (i < n64) mn = fminf(mn, v[i]); }
        float hi = wave_max_f_dpp(mx), lo = -wave_max_f_dpp(-mn);
        hi = __builtin_bit_cast(float, __builtin_bit_cast(int, hi) + (hi >= 0.f ? 1 : -1));
        thr = lo;
        for (int it = 0; it < 64; ++it) {
            const float mid = 0.5f * lo + 0.5f * hi;
            if (!(mid > lo) || !(mid < hi)) break;
            int c0 = 0, c1 = 0, c2 = 0, c3 = 0;
#pragma unroll
            for (int i = 0; i < NR; i += 4) {
                unsigned long long m0, m1, m2, m3;
                asm volatile("v_cmp_ge_f32_e64 %[m0], %[a0], %[md]\n\tv_cmp_ge_f32_e64 %[m1], %[a1], %[md]\n\tv_cmp_ge_f32_e64 %[m2], %[a2], %[md]\n\tv_cmp_ge_f32_e64 %[m3], %[a3], %[md]\n\t"
                             "v_addc_co_u32_e64 %[c0], %[m0], 0, %[c0], %[m0]\n\tv_addc_co_u32_e64 %[c1], %[m1], 0, %[c1], %[m1]\n\tv_addc_co_u32_e64 %[c2], %[m2], 0, %[c2], %[m2]\n\tv_addc_co_u32_e64 %[c3], %[m3], 0, %[c3], %[m3]"
                             : [c0] "+v"(c0), [c1] "+v"(c1), [c2] "+v"(c2), [c3] "+v"(c3), [m0] "=&s"(m0), [m1] "=&s"(m1), [m2] "=&s"(m2), [m3] "=&s"(m3)
                             : [a0] "v"(v[i]), [a1] "v"(v[i + 1]), [a2] "v"(v[i + 2]), [a3] "v"(v[i + 3]), [md] "v"(mid));
            }
            const int c = wave_sum_i_dpp((c0 + c1) + (c2 + c3));
            if (c >= TOPK) { lo = mid; thr = mid; } else hi = mid;
            if (c == TOPK) break;
        }
    }
    unsigned long long w = 0ull;
#pragma unroll
    for (int i = 0; i < NR; ++i) { const unsigned long long bb = __ballot((i < n64) && (v[i] >= thr)); if (lane == i) w = bb; }
    bmrow[lane] = w;
}
__device__ __forceinline__ void p3_select(const Ctx& C, const Args& a) {
    unsigned char* ws = a.ws;
    const float* SC = (const float*)(ws + WS_SC); unsigned long long* BM = (unsigned long long*)(ws + WS_BM);
    const int gw = C.vcu * NWAVES + C.wave, NGW = C.G * NWAVES, lane = C.lane;
    for (int row = gw; row < T; row += NGW) {
        const int s = row & (S - 1), n64 = (s >> 6) + 1;
        const float* sr = SC + (size_t)row * 4096 + lane;
        unsigned long long* bm = BM + (size_t)row * 64;
        if (n64 <= 16) p3_select_row<16, const float*>(sr, n64, bm, lane);
        else if (n64 <= 32) p3_select_row<32, const float*>(sr, n64, bm, lane);
        else if (n64 <= 48) p3_select_row<48, const float*>(sr, n64, bm, lane);
        else p3_select_row<64, const float*>(sr, n64, bm, lane);
    }
}

template <bool WAIT>
__device__ __forceinline__ void p23_index_select(const Ctx& C, const Args& a) {
    unsigned char* ws = a.ws;
    const bf16_t* QI = (const bf16_t*)(ws + WS_QI); const bf16_t* KI = (const bf16_t*)(ws + WS_KI); const float* WI = (const float*)(ws + WS_WI);
    unsigned long long* BM = (unsigned long long*)(ws + WS_BM);
    LAS float* rowbuf = (LAS float*)C.lds;
    LAS float* wq = (LAS float*)(C.lds + 131072);
    const int tid = C.tid, lane = C.lane, wid = C.wave, r = lane & 31, hh = lane >> 5;
    unsigned* qd = (unsigned*)(ws + WS_QCNT) + 64 * 17;
    LAS int* slot = (LAS int*)(C.lds + LDS_BYTES - 128);
    if (tid == 0) {
        if (WAIT) {
            const unsigned* dc = (const unsigned*)(ws + WS_QCNT) + 64 * 18;
            while (__hip_atomic_load(dc, __ATOMIC_RELAXED, __HIP_MEMORY_SCOPE_AGENT) < (unsigned)P1_IDX_TILES) __builtin_amdgcn_s_sleep(16);
            __builtin_amdgcn_fence(__ATOMIC_ACQUIRE, "agent");
        }
        *slot = (int)__hip_atomic_fetch_add(qd, 1u, __ATOMIC_RELAXED, __HIP_MEMORY_SCOPE_AGENT);
    }
    __syncthreads();
    int pcur = __builtin_amdgcn_readfirstlane(*slot);
#define P23_SUB(PI, B_, Q0_, N64_) do { const int pi_ = (PI); B_ = pi_ & 1; const int s0_ = (511 - (pi_ >> 1)) * 8; N64_ = (s0_ >> 6) + 1; Q0_ = B_ * S + s0_; } while (0)
#define P23_LOADA(DST, Q0_) do { _Pragma("unroll") for (int rt = 0; rt < 4; ++rt) { const int i_ = rt * 32 + r; \
        _Pragma("unroll") for (int ks = 0; ks < 4; ++ks) DST[rt][ks] = *(const bf16x8*)(QI + (size_t)((Q0_) + (i_ >> 4)) * 1024 + (i_ & 15) * 64 + ks * 16 + hh * 8); } } while (0)
#define P23_LOADB0(B_, N64_) do { if (wid < 2 * (N64_)) { _Pragma("unroll") for (int ks = 0; ks < 4; ++ks) bfrag[ks] = *(const bf16x8*)(KI + (size_t)((B_) * S + wid * 32 + r) * 64 + ks * 16 + hh * 8); } } while (0)
    bf16x8 afn[4][4], bfrag[4]; float wqn = 0.f;
    if (pcur < 1024) { int b0, q00, n0; P23_SUB(pcur, b0, q00, n0); P23_LOADA(afn, q00); P23_LOADB0(b0, n0); if (tid < 128) wqn = WI[(size_t)(q00 + (tid >> 4)) * 16 + (tid & 15)]; }
    while (pcur < 1024) {
        int b, q0, n64; P23_SUB(pcur, b, q0, n64);
        __syncthreads();
        if (tid < 128) wq[tid] = wqn;
        unsigned tk = 0u;
        if (tid == 0) tk = __hip_atomic_fetch_add(qd, 1u, __ATOMIC_RELAXED, __HIP_MEMORY_SCOPE_AGENT);
        bf16x8 afr[4][4];
#pragma unroll
        for (int rt = 0; rt < 4; ++rt)
#pragma unroll
            for (int ks = 0; ks < 4; ++ks) afr[rt][ks] = afn[rt][ks];
        __syncthreads();
        const int ntile = n64 * 2;
        for (int kt = wid; kt < ntile; kt += 8) {
            bf16x8 bcur[4];
#pragma unroll
            for (int ks = 0; ks < 4; ++ks) bcur[ks] = bfrag[ks];
            if (kt + 8 < ntile) {
#pragma unroll
                for (int ks = 0; ks < 4; ++ks) bfrag[ks] = *(const bf16x8*)(KI + (size_t)(b * S + (kt + 8) * 32 + r) * 64 + ks * 16 + hh * 8);
            }
#define P23_CHAIN(ACC, RT) do { ACC = f32x16{}; _Pragma("unroll") for (int ks = 0; ks < 4; ++ks) ACC = __builtin_amdgcn_mfma_f32_32x32x16_bf16(afr[RT][ks], bcur[ks], ACC, 0, 0, 0); } while (0)
#define RELU(x) __builtin_amdgcn_fmed3f((x), 0.f, pinf)
            const float pinf = 3.0e38f;
            f32x16 accs[2];
            P23_CHAIN(accs[0], 0);
#pragma unroll
            for (int rt = 0; rt < 4; ++rt) {
                if (rt < 3) P23_CHAIN(accs[(rt + 1) & 1], rt + 1);
                const f32x16 acc = accs[rt & 1];
                const LAS float* wp = wq + rt * 32 + 4 * hh;
                const f32x4 w0 = *(const LAS f32x4*)(wp), w1 = *(const LAS f32x4*)(wp + 8), w2 = *(const LAS f32x4*)(wp + 16), w3 = *(const LAS f32x4*)(wp + 24);
                float sA = w0.x * RELU(acc[0]); sA = fmaf(w0.y, RELU(acc[1]), sA); sA = fmaf(w0.z, RELU(acc[2]), sA); sA = fmaf(w0.w, RELU(acc[3]), sA);
                sA = fmaf(w1.x, RELU(acc[4]), sA); sA = fmaf(w1.y, RELU(acc[5]), sA); sA = fmaf(w1.z, RELU(acc[6]), sA); sA = fmaf(w1.w, RELU(acc[7]), sA);
                float sB = w2.x * RELU(acc[8]); sB = fmaf(w2.y, RELU(acc[9]), sB); sB = fmaf(w2.z, RELU(acc[10]), sB); sB = fmaf(w2.w, RELU(acc[11]), sB);
                sB = fmaf(w3.x, RELU(acc[12]), sB); sB = fmaf(w3.y, RELU(acc[13]), sB); sB = fmaf(w3.z, RELU(acc[14]), sB); sB = fmaf(w3.w, RELU(acc[15]), sB);
                const auto sw = __builtin_amdgcn_permlane32_swap(__float_as_uint(sA), __float_as_uint(sB), false, false);
                const float tot = __uint_as_float(sw[0]) + __uint_as_float(sw[1]);
                rowbuf[(2 * rt + hh) * 4096 + kt * 32 + r] = tot;
            }
#undef P23_CHAIN
#undef RELU
        }
        if (tid == 0) *slot = (int)tk;
        __syncthreads();
        const int pnext = __builtin_amdgcn_readfirstlane(*slot);
        if (pnext < 1024) { int bn, qn, nn; P23_SUB(pnext, bn, qn, nn); P23_LOADA(afn, qn); P23_LOADB0(bn, nn); if (tid < 128) wqn = WI[(size_t)(qn + (tid >> 4)) * 16 + (tid & 15)]; }
        {
            const LAS float* sr = rowbuf + wid * 4096 + lane;
            unsigned long long* bm = BM + (size_t)(q0 + wid) * 64;
            if (n64 <= 16) p3_select_row<16, const LAS float*>(sr, n64, bm, lane);
            else if (n64 <= 32) p3_select_row<32, const LAS float*>(sr, n64, bm, lane);
            else if (n64 <= 48) p3_select_row<48, const LAS float*>(sr, n64, bm, lane);
            else p3_select_row<64, const LAS float*>(sr, n64, bm, lane);
        }
        pcur = pnext;
    }
#undef P23_SUB
#undef P23_LOADA
#undef P23_LOADB0
}

__device__ __forceinline__ at::BlockRef ref_dsa(unsigned char* ws, const float* gains, int b, int h, int qb) {
    at::BlockRef r; const size_t row0 = (size_t)b * S + (size_t)qb * 256;
    r.Q = (const bf16_t*)(ws + WS_QB) + row0 * 1024 + h * 128;
    r.K = (const bf16_t*)(ws + WS_KB) + (size_t)b * S * 1024 + h * 128;
    r.V = (const bf16_t*)(ws + WS_VBB) + (size_t)b * S * 1024 + h * 128;
    r.O = (bf16_t*)(ws + WS_O) + row0 * 2048 + 1024 + h * 128;
    r.qb = qb; r.gains = gains; r.bm = (const unsigned long long*)(ws + WS_BM) + row0 * 64; r.bias = nullptr;
    return r;
}
__device__ __forceinline__ at::BlockRef ref_mixa(unsigned char* ws, const float* rel_bias, const float* gains, int b, int h, int qb) {
    at::BlockRef r; const size_t row0 = (size_t)b * S + (size_t)qb * 256;
    r.Q = (const bf16_t*)(ws + WS_QA) + row0 * 1024 + h * 128;
    r.K = (const bf16_t*)(ws + WS_KA) + (size_t)b * S * 1024 + h * 128;
    r.V = (const bf16_t*)(ws + WS_VA) + (size_t)b * S * 1024 + h * 128;
    r.O = (bf16_t*)(ws + WS_O) + row0 * 2048 + h * 128;
    r.qb = qb; r.gains = gains; r.bm = nullptr; r.bias = rel_bias + h * 257;
    return r;
}
__device__ __forceinline__ void p4_attention(const Ctx& C, const Args& a, char* lds) {
    unsigned char* ws = a.ws;
    for (int v = C.bid; v < 256; v += C.G) {
        const int xcd = v & 7, slot = v >> 3;
        const int bh = 2 * xcd + (slot & 1), g = slot >> 1;
        const int b = bh >> 3, h = bh & 7;
        {
            at::Seam S;
            const at::BlockRef cur = ref_dsa(ws, a.in[6], b, h, 15 - g);
            at::attn_prime<1>(cur, lds, S);
            at::attn_block<1>(cur, cur, lds, S);
        }
        int q0 = 0, q1 = -1;
        if (g == 15) { q0 = 0; q1 = 4; } else if (g == 14) { q0 = 5; q1 = 8; } else if (g == 13) { q0 = 9; q1 = 12; } else if (g == 12) { q0 = 13; q1 = 15; }
        if (q0 <= q1) {
            at::Seam S;
            at::BlockRef cur = ref_mixa(ws, a.in[7], a.in[5], b, h, q0);
            at::attn_prime<0>(cur, lds, S);
            for (int qb = q0; qb <= q1; ++qb) {
                const at::BlockRef nxt = (qb < q1) ? ref_mixa(ws, a.in[7], a.in[5], b, h, qb + 1) : cur;
                at::attn_block<0>(cur, nxt, lds, S);
                cur = nxt;
            }
        }
    }
    {
        unsigned* qd = (unsigned*)(ws + WS_QCNT) + 64 * 16;
        LAS int* slot = (LAS int*)(C.lds + LDS_BYTES - 128);
        for (;;) {
            __syncthreads();
            if (C.tid == 0) *slot = (int)__hip_atomic_fetch_add(qd, 1u, __ATOMIC_RELAXED, __HIP_MEMORY_SCOPE_AGENT);
            __syncthreads();
            const int task = *slot;
            if (task >= DT_N) break;
            p0_task(C, a, task);
        }
    }
}
struct EpiOutProj {
    static constexpr bool PERM = false, AFTER_DRAIN = false;
    const bf16_t* xb; bf16_t* h1b;
    __device__ __forceinline__ void operator()(const f32x4 (&acc)[2][2][4][2], const pg8::Unit& u, int wr, int wc, int fr, int fq) const {
        const int row0 = u.pm * 256 + wr * 64 + fr, col0 = u.pn * 256 + wc * 32 + 4 * fq;
#pragma unroll
        for (int ai = 0; ai < 2; ++ai)
#pragma unroll
            for (int m = 0; m < 4; ++m) {
                const size_t ro = (size_t)(row0 + ai * 128 + m * 16) * D + col0;
#pragma unroll
                for (int bj = 0; bj < 2; ++bj)
#pragma unroll
                    for (int n = 0; n < 2; ++n) {
                        const size_t o = ro + bj * 128 + n * 16;
                        const u32x2 xw = *(const u32x2*)(xb + o);
                        f32x4 v = acc[ai][bj][m][n];
                        v.x += __builtin_bit_cast(float, xw.x << 16); v.y += __builtin_bit_cast(float, xw.x & 0xffff0000u);
                        v.z += __builtin_bit_cast(float, xw.y << 16); v.w += __builtin_bit_cast(float, xw.y & 0xffff0000u);
                        u32x2 w; w.x = pk2(v.x, v.y); w.y = pk2(v.z, v.w);
                        *(u32x2*)(h1b + o) = w;
                    }
            }
    }
};
struct EpiBf16Plain {
    static constexpr bool PERM = false, AFTER_DRAIN = false;
    bf16_t* O; int ldc;
    __device__ __forceinline__ void operator()(const f32x4 (&acc)[2][2][4][2], const pg8::Unit& u, int wr, int wc, int fr, int fq) const {
        const int row0 = u.pm * 256 + wr * 64 + fr, col0 = u.pn * 256 + wc * 32 + 4 * fq;
#pragma unroll
        for (int ai = 0; ai < 2; ++ai)
#pragma unroll
            for (int m = 0; m < 4; ++m) {
                const size_t ro = (size_t)(row0 + ai * 128 + m * 16) * ldc + col0;
#pragma unroll
                for (int bj = 0; bj < 2; ++bj)
#pragma unroll
                    for (int n = 0; n < 2; ++n) {
                        const f32x4 v = acc[ai][bj][m][n];
                        u32x2 w; w.x = pk2(v.x, v.y); w.y = pk2(v.z, v.w);
                        *(u32x2*)(O + ro + bj * 128 + n * 16) = w;
                    }
            }
    }
};
struct EpiBf16I8 {
    static constexpr bool PERM = false, AFTER_DRAIN = false;
    bf16_t* O; int ldc; const float* sa; const float* sw;
    __device__ __forceinline__ void operator()(const pg8::i32x4 (&acc)[2][2][4][2], const pg8::Unit& u, int wr, int wc, int fr, int fq) const {
        const int row0 = u.pm * 256 + wr * 64 + fr, col0 = u.pn * 256 + wc * 32 + 4 * fq;
        f32x4 swv[2][2];
#pragma unroll
        for (int bj = 0; bj < 2; ++bj)
#pragma unroll
            for (int n = 0; n < 2; ++n) swv[bj][n] = *(const f32x4*)(sw + col0 + bj * 128 + n * 16);
#pragma unroll
        for (int ai = 0; ai < 2; ++ai)
#pragma unroll
            for (int m = 0; m < 4; ++m) {
                const int row = row0 + ai * 128 + m * 16;
                const size_t ro = (size_t)row * ldc + col0; const float sar = sa[row];
#pragma unroll
                for (int bj = 0; bj < 2; ++bj)
#pragma unroll
                    for (int n = 0; n < 2; ++n) {
                        const f32x4 v = __builtin_convertvector(acc[ai][bj][m][n], f32x4) * swv[bj][n] * sar;
                        u32x2 w; w.x = pk2(v.x, v.y); w.y = pk2(v.z, v.w);
                        *(u32x2*)(O + ro + bj * 128 + n * 16) = w;
                    }
            }
    }
};
struct EpiF32Plain {
    static constexpr bool PERM = false, AFTER_DRAIN = false;
    float* Cp; int ldc;
    __device__ __forceinline__ void operator()(const f32x4 (&acc)[2][2][4][2], const pg8::Unit& u, int wr, int wc, int fr, int fq) const {
        const int row0 = u.pm * 256 + wr * 64 + fr, col0 = u.pn * 256 + wc * 32 + 4 * fq;
#pragma unroll
        for (int ai = 0; ai < 2; ++ai)
#pragma unroll
            for (int m = 0; m < 4; ++m) {
                const size_t ro = (size_t)(row0 + ai * 128 + m * 16) * ldc + col0;
#pragma unroll
                for (int bj = 0; bj < 2; ++bj)
#pragma unroll
                    for (int n = 0; n < 2; ++n) *(f32x4*)(Cp + ro + bj * 128 + n * 16) = acc[ai][bj][m][n];
            }
    }
};
struct EpiPle {
    static constexpr bool PERM = false, AFTER_DRAIN = false;
    const float* rs3; const bf16_t* pp; const bf16_t* h2b; float* out; const float* sa; const float* sw;
    __device__ __forceinline__ void operator()(const pg8::i32x4 (&acc)[2][2][4][2], const pg8::Unit& u, int wr, int wc, int fr, int fq) const {
        const int row0 = u.pm * 256 + wr * 64 + fr, col0 = u.pn * 256 + wc * 32 + 4 * fq;
        f32x4 swv[2][2];
#pragma unroll
        for (int bj = 0; bj < 2; ++bj)
#pragma unroll
            for (int n = 0; n < 2; ++n) swv[bj][n] = *(const f32x4*)(sw + col0 + bj * 128 + n * 16);
#pragma unroll
        for (int ai = 0; ai < 2; ++ai)
#pragma unroll
            for (int m = 0; m < 4; ++m) {
                const int row = row0 + ai * 128 + m * 16;
                const f32x4 q0 = *(const f32x4*)(rs3 + (size_t)row * 8), q1 = *(const f32x4*)(rs3 + (size_t)row * 8 + 4);
                const float r = rsqrtf(((q0.x + q0.y) + (q0.z + q0.w) + (q1.x + q1.y) + (q1.z + q1.w)) * (1.0f / D) + EPS) * -1.4426950408889634f * sa[row];
                const size_t ro = (size_t)row * D + col0;
#pragma unroll
                for (int bj = 0; bj < 2; ++bj)
#pragma unroll
                    for (int n = 0; n < 2; ++n) {
                        const size_t o = ro + bj * 128 + n * 16;
                        const f32x4 a4 = __builtin_convertvector(acc[ai][bj][m][n], f32x4) * swv[bj][n]; const u32x2 qw = *(const u32x2*)(pp + o), hw = *(const u32x2*)(h2b + o);
                        f32x4 h;
                        h.x = __builtin_bit_cast(float, hw.x << 16) + __builtin_bit_cast(float, qw.x << 16) * __builtin_amdgcn_rcpf(1.0f + __builtin_amdgcn_exp2f(a4.x * r));
                        h.y = __builtin_bit_cast(float, hw.x & 0xffff0000u) + __builtin_bit_cast(float, qw.x & 0xffff0000u) * __builtin_amdgcn_rcpf(1.0f + __builtin_amdgcn_exp2f(a4.y * r));
                        h.z = __builtin_bit_cast(float, hw.y << 16) + __builtin_bit_cast(float, qw.y << 16) * __builtin_amdgcn_rcpf(1.0f + __builtin_amdgcn_exp2f(a4.z * r));
                        h.w = __builtin_bit_cast(float, hw.y & 0xffff0000u) + __builtin_bit_cast(float, qw.y & 0xffff0000u) * __builtin_amdgcn_rcpf(1.0f + __builtin_amdgcn_exp2f(a4.w * r));
                        *(f32x4*)(out + o) = h;
                    }
            }
    }
};
constexpr size_t WS_QV = 288 * MiB;

__device__ __forceinline__ void p5_outproj(const Ctx& C, const Args& a) {
    unsigned char* ws = a.ws;
    pg8::Gemm g{(const bf16_t*)(ws + WS_O), (const bf16_t*)(ws + WS_WOUT), T, D, D};
    pg8::StaticOrder S; S.init(T, D, C.G, C.bid);
    EpiOutProj E{(const bf16_t*)(ws + WS_XB), (bf16_t*)(ws + WS_H1B)};
    pg8::gemm_phase<EpiOutProj, pg8::StaticOrder, true, true>(C.lds, g, S, E);
}
__device__ __forceinline__ void p5b_tokprep(const Ctx& C, const Args& a) {
    unsigned char* ws = a.ws;
    const int lane = C.lane, gw = C.vcu * NWAVES + C.wave, NGW = C.G * NWAVES;
    for (int t = gw; t < T; t += NGW) {
        const bf16_t* h1r = (const bf16_t*)(ws + WS_H1B) + (size_t)t * D + lane * 16;
        f32x4 x[8];
        float ss = 0.f;
#pragma unroll
        for (int j = 0; j < 2; ++j)
#pragma unroll
            for (int q = 0; q < 2; ++q) { const u32x4 w = *(const u32x4*)(h1r + 1024 * j + 8 * q);
                x[4 * j + 2 * q] = (f32x4){__builtin_bit_cast(float, w.x << 16), __builtin_bit_cast(float, w.x & 0xffff0000u), __builtin_bit_cast(float, w.y << 16), __builtin_bit_cast(float, w.y & 0xffff0000u)};
                x[4 * j + 2 * q + 1] = (f32x4){__builtin_bit_cast(float, w.z << 16), __builtin_bit_cast(float, w.z & 0xffff0000u), __builtin_bit_cast(float, w.w << 16), __builtin_bit_cast(float, w.w & 0xffff0000u)}; }
#pragma unroll
        for (int j = 0; j < 8; ++j) ss += (x[j].x * x[j].x + x[j].y * x[j].y) + (x[j].z * x[j].z + x[j].w * x[j].w);
        const float rs2 = rsqrtf(wave_sum(ss) * (1.0f / D) + EPS);
        {
            float mh = 0.f;
#pragma unroll
            for (int j = 0; j < 8; ++j) mh = fmaxf(fmaxf(mh, fmaxf(fabsf(x[j].x), fabsf(x[j].y))), fmaxf(fabsf(x[j].z), fabsf(x[j].w)));
#pragma unroll
            for (int o = 1; o < 64; o <<= 1) mh = fmaxf(mh, __shfl_xor(mh, o));
            if (lane == 0) ((float*)(ws + WS_AMAX1))[t] = mh;
        }
        const float* gf = a.in[9] + lane * 16;
        f32x4 y[8]; float mx = 0.f;
#pragma unroll
        for (int j = 0; j < 2; ++j)
#pragma unroll
            for (int q = 0; q < 4; ++q) { const f32x4 g4 = *(const f32x4*)(gf + 1024 * j + 4 * q); const f32x4 yy = x[4 * j + q] * g4 * rs2; y[4 * j + q] = yy;
                mx = fmaxf(fmaxf(mx, fmaxf(fabsf(yy.x), fabsf(yy.y))), fmaxf(fabsf(yy.z), fabsf(yy.w))); }
#pragma unroll
        for (int o = 1; o < 64; o <<= 1) mx = fmaxf(mx, __shfl_xor(mx, o));
        const float inv = mx > 0.f ? 127.0f / mx : 0.f;
        if (lane == 0) ((float*)(ws + WS_SX))[t] = mx * (1.0f / 127.0f);
        unsigned xw[8];
#pragma unroll
        for (int i = 0; i < 8; ++i)
            xw[i] = ((unsigned)(int)rintf(y[i].x * inv) & 0xffu) | (((unsigned)(int)rintf(y[i].y * inv) & 0xffu) << 8) | (((unsigned)(int)rintf(y[i].z * inv) & 0xffu) << 16) | (((unsigned)(int)rintf(y[i].w * inv) & 0xffu) << 24);
        unsigned char* xo = ws + WS_X8 + (size_t)t * D + lane * 16;
        u32x4 w0 = {xw[0], xw[1], xw[2], xw[3]}, w1 = {xw[4], xw[5], xw[6], xw[7]};
        *(u32x4*)xo = w0; *(u32x4*)(xo + 1024) = w1;
    }
}
__device__ __forceinline__ void p6_peerq_pp(const Ctx& C, const Args& a, bool pp_part) {
    unsigned char* ws = a.ws;
    if (!pp_part) {
        pg8::Gemm g{(const bf16_t*)(ws + WS_X8), (const bf16_t*)(ws + WS_WPQ8), T, D, D / 2};
        pg8::StaticOrder S; S.init(T, D, C.G, C.bid);
        EpiBf16I8 E{(bf16_t*)(ws + WS_QV), D, (const float*)(ws + WS_SX), (const float*)(ws + WS_SWPQ)};
        pg8::gemm_phase<EpiBf16I8, pg8::StaticOrder, true, true, true>(C.lds, g, S, E);
    } else {
        pg8::Gemm g{(const bf16_t*)(ws + WS_PB), (const bf16_t*)(ws + WS_WP), T, D, PLE};
        pg8::StaticOrder S; S.init(T, D, C.G, C.bid);
        EpiBf16Plain E{(bf16_t*)(ws + WS_PP), D};
        pg8::gemm_phase<EpiBf16Plain, pg8::StaticOrder, true, true>(C.lds, g, S, E);
    }
}
__device__ __forceinline__ void p8_quant_h2(const Ctx& C, const Args& a) {
    unsigned char* ws = a.ws;
    const int gw = C.vcu * NWAVES + C.wave, NGW = C.G * NWAVES;
    for (int m = gw; m < T; m += NGW) p0_quant_row((const bf16_t*)(ws + WS_XB) + (size_t)m * D, ws + WS_H2Q + (size_t)m * D, (float*)(ws + WS_SAH2) + m, C.lane);
}
__device__ __forceinline__ void p8_ple(const Ctx& C, const Args& a) {
    unsigned char* ws = a.ws;
    pg8::Gemm g{(const bf16_t*)(ws + WS_H2Q), (const bf16_t*)(ws + WS_WG8), T, D, D / 2};
    pg8::StaticOrder S; S.init(T, D, C.G, C.bid);
    EpiPle E{(const float*)(ws + WS_SSQP), (const bf16_t*)(ws + WS_PP), (const bf16_t*)(ws + WS_XB), a.out, (const float*)(ws + WS_SAH2), (const float*)(ws + WS_SWG)};
    pg8::gemm_phase<EpiPle, pg8::StaticOrder, true, true, true>(C.lds, g, S, E);
}

#define CE_DESC(x, y) do { const unsigned _mx = (x) > (y) ? (x) : (y), _mn = (x) > (y) ? (y) : (x); (x) = _mx; (y) = _mn; } while (0)
#define CE_ASC(x, y)  do { const unsigned _mx = (x) > (y) ? (x) : (y), _mn = (x) > (y) ? (y) : (x); (x) = _mn; (y) = _mx; } while (0)
__device__ __forceinline__ void sort16_desc(unsigned (&v)[16]) {
#pragma unroll
    for (int k = 2; k <= 16; k <<= 1)
#pragma unroll
        for (int j = k >> 1; j > 0; j >>= 1)
#pragma unroll
            for (int i = 0; i < 16; ++i) { const int l = i ^ j; if (l > i) { if ((i & k) == 0) CE_DESC(v[i], v[l]); else CE_ASC(v[i], v[l]); } }
}
__device__ __forceinline__ void merge_top16(unsigned (&a)[16], const unsigned (&b)[16]) {
#pragma unroll
    for (int i = 0; i < 16; ++i) a[i] = a[i] > b[15 - i] ? a[i] : b[15 - i];
#pragma unroll
    for (int j = 8; j > 0; j >>= 1)
#pragma unroll
        for (int i = 0; i < 16; ++i) { const int l = i ^ j; if (l > i) CE_DESC(a[i], a[l]); }
}
__device__ __forceinline__ void top16_of_64(unsigned (&g0)[16], unsigned (&g1)[16], unsigned (&g2)[16], unsigned (&g3)[16]) {
    sort16_desc(g0); sort16_desc(g1); sort16_desc(g2); sort16_desc(g3);
    merge_top16(g0, g1); merge_top16(g2, g3); merge_top16(g0, g2);
}
__device__ __forceinline__ unsigned skey_u(unsigned u) { return u ^ ((unsigned)((int)u >> 31) | 0x80000000u); }
__device__ __forceinline__ float unskey_f(unsigned k) { const unsigned u = (k & 0x80000000u) ? (k & 0x7fffffffu) : ~k; return __builtin_bit_cast(float, u); }
__device__ __forceinline__ float gelu_tanh_f(float x) {
    const float u = 0.7978845608028654f * (x + 0.044715f * x * x * x);
    const float e = __builtin_amdgcn_exp2f(u * 2.885390081777927f);
    const float th = 1.0f - 2.0f * __builtin_amdgcn_rcpf(e + 1.0f);
    return 0.5f * x * (1.0f + th);
}
typedef __bf16 bf16x2_t __attribute__((ext_vector_type(2)));
__device__ __forceinline__ float dot2bf(unsigned a, unsigned b, float c) { return __builtin_amdgcn_fdot2_f32_bf16(__builtin_bit_cast(bf16x2_t, a), __builtin_bit_cast(bf16x2_t, b), c, false); }

__device__ __forceinline__ void p7a_route(const Ctx& C, const Args& a, bool tile_mode, int pm, int pn) {
    unsigned char* ws = a.ws;
    LAS unsigned char* lds = C.lds;
    constexpr int OFF_SK = 0, OFF_EXP = 65536, OFF_SCS = 81920, OFF_TAB = 98304, OFF_CF = 131072;
    const int tid = C.tid, lane = C.lane, wid = C.wave, r32 = lane & 31, hi = lane >> 5;
    const bf16_t* QV = (const bf16_t*)(ws + WS_QV);
    __syncthreads();
    {
        const u32x4* src = (const u32x4*)(ws + WS_SUBK);
#pragma unroll
        for (int i = 0; i < 8; ++i) { const int c = tid + 512 * i, row = c >> 4, ch = c & 15; *(LAS u32x4*)(lds + OFF_SK + row * 256 + ((ch ^ (row & 15)) << 4)) = src[c]; }
    }
    __syncthreads();
    for (int blk = tile_mode ? 0 : C.vcu; blk < (tile_mode ? 1 : T / 32); blk += C.G) {
        const int t0 = tile_mode ? pm * 256 + 32 * wid : blk * 32;
        {
            const int h = tile_mode ? pn : wid;
            LAS unsigned* tab = (LAS unsigned*)(lds + OFF_TAB + wid * 4096 + r32 * 128);
#pragma unroll
            for (int half = 0; half < 2; ++half) {
                f32x16 acc[4]; acc[0] = f32x16{}; acc[1] = f32x16{}; acc[2] = f32x16{}; acc[3] = f32x16{};
                const bf16_t* qp = QV + (size_t)(t0 + r32) * 2048 + h * 256 + half * 128 + hi * 8;
#pragma unroll 2
                for (int ks = 0; ks < 8; ++ks) {
                    const bf16x8 qf = *(const bf16x8*)(qp + ks * 16);
#pragma unroll
                    for (int kt = 0; kt < 4; ++kt) {
                        const int row = half * 128 + kt * 32 + r32, ch = ks * 2 + hi;
#ifdef P7_SK_GLOBAL
                        const bf16x8 af = *(const bf16x8*)((const bf16_t*)(ws + WS_SUBK) + (size_t)row * 128 + ch * 8);
#else
                        const bf16x8 af = *(const LAS bf16x8*)(lds + OFF_SK + row * 256 + ((ch ^ (row & 15)) << 4));
#endif
                        acc[kt] = __builtin_amdgcn_mfma_f32_32x32x16_bf16(af, qf, acc[kt], 0, 0, 0);
                    }
                }
#ifdef P7_DEBUG_SCORE
                if (hi == 0) { float* dbf = (float*)(ws + WS_GATE) + ((size_t)(t0 + r32) * 8 + h) * 4 + half * 2; dbf[0] = acc[0][0]; dbf[1] = acc[3][15]; }
#endif
                unsigned hi4 = (unsigned)hi << 2; asm volatile("" : "+v"(hi4));
                unsigned g0[16], g1[16], g2[16], g3[16];
#pragma unroll
                for (int r = 0; r < 16; ++r) {
                    const unsigned base = (unsigned)((r & 3) + 8 * (r >> 2));
                    { const float sv = acc[0][r]; g0[r] = ((skey_u(__float_as_uint(sv)) & ~127u) | ((base + 0u) ^ 127u)) ^ hi4; }
                    { const float sv = acc[1][r]; g1[r] = ((skey_u(__float_as_uint(sv)) & ~127u) | ((base + 32u) ^ 127u)) ^ hi4; }
                    { const float sv = acc[2][r]; g2[r] = ((skey_u(__float_as_uint(sv)) & ~127u) | ((base + 64u) ^ 127u)) ^ hi4; }
                    { const float sv = acc[3][r]; g3[r] = ((skey_u(__float_as_uint(sv)) & ~127u) | ((base + 96u) ^ 127u)) ^ hi4; }
                }
#ifdef P7_SLOW_SORT
                { unsigned outl[16];
#pragma unroll
                  for (int it = 0; it < 16; ++it) { unsigned m = 0u;
#pragma unroll
                      for (int i = 0; i < 16; ++i) { m = m > g0[i] ? m : g0[i]; m = m > g1[i] ? m : g1[i]; m = m > g2[i] ? m : g2[i]; m = m > g3[i] ? m : g3[i]; }
                      outl[it] = m;
#pragma unroll
                      for (int i = 0; i < 16; ++i) { g0[i] = g0[i] == m ? 0u : g0[i]; g1[i] = g1[i] == m ? 0u : g1[i]; g2[i] = g2[i] == m ? 0u : g2[i]; g3[i] = g3[i] == m ? 0u : g3[i]; } }
#pragma unroll
                  for (int i = 0; i < 16; ++i) g0[i] = outl[i]; }
#else
                top16_of_64(g0, g1, g2, g3);
#endif
#ifdef P7_DEBUG_TOP1
                { unsigned* dbg = (unsigned*)(ws + WS_EXP) + ((size_t)(t0 + r32) * 8 + h) * 32 + half * 16;
#pragma unroll
                  for (int i = 0; i < 8; ++i) dbg[hi * 8 + i] = g0[i]; }
#endif
                unsigned pa[16], pb[16];
#pragma unroll
                for (int i = 0; i < 16; ++i) { auto rr = __builtin_amdgcn_permlane32_swap(g0[i], g0[i], false, false); pa[i] = rr[0]; pb[i] = rr[1]; }
                merge_top16(pa, pb);
                if (hi == 0) {
#pragma unroll
                    for (int i = 0; i < 16; ++i) tab[half * 16 + i] = pa[i];
                }
#ifdef P7_DEBUG_LISTS
                if (hi == 0) { unsigned* dbg = (unsigned*)(ws + WS_EXP) + ((size_t)(t0 + r32) * 8 + h) * 32 + half * 16;
#pragma unroll
                    for (int i = 0; i < 16; ++i) dbg[i] = pa[i]; }
#endif
                asm volatile("s_waitcnt lgkmcnt(0)" ::: "memory");
                __builtin_amdgcn_sched_barrier(0);
            }
            float f1[16], f2[16];
#pragma unroll
            for (int i = 0; i < 16; ++i) { f1[i] = unskey_f(tab[i] & ~127u); f2[i] = unskey_f(tab[16 + i] & ~127u); }
            unsigned c0[16], c1[16], c2[16], c3[16];
            {
                int cnt = 0;
#pragma unroll
                for (int aa = 0; aa < 16; ++aa)
#pragma unroll
                    for (int bb = 0; bb < 16; ++bb)
                        if ((aa + 1) * (bb + 1) <= 16) {
                            const float sm = f1[aa] + f2[bb];
                            const unsigned pk = (skey_u(__builtin_bit_cast(unsigned, sm)) & ~255u) | (255u - (unsigned)(aa * 16 + bb));
                            const int slot = cnt++;
                            if (slot < 16) c0[slot & 15] = pk; else if (slot < 32) c1[slot & 15] = pk; else if (slot < 48) c2[slot & 15] = pk; else c3[slot & 15] = pk;
                        }
#pragma unroll
                for (int s2 = 2; s2 < 16; ++s2) c3[s2] = 0u;
            }
            top16_of_64(c0, c1, c2, c3);
            asm volatile("s_waitcnt lgkmcnt(0)" ::: "memory");
            if (hi == 0) {
                float gsc[16]; float sm = 0.f;
                const float m0 = unskey_f(c0[0] & ~255u);
#pragma unroll
                for (int i = 0; i < 16; ++i) { gsc[i] = __builtin_amdgcn_exp2f((unskey_f(c0[i] & ~255u) - m0) * 1.4426950408889634f); sm += gsc[i]; }
                const float rsm = 1.0f / sm;
                int eid[16];
#pragma unroll
                for (int i = 0; i < 16; ++i) {
                    const unsigned ci = 255u - (c0[i] & 255u);
                    const unsigned e1 = 127u - (tab[ci >> 4] & 127u), e2 = 127u - (tab[16 + (ci & 15u)] & 127u);
                    eid[i] = (int)(e1 * 128u + e2);
                }
                float* gp = (float*)(ws + WS_GATE) + (size_t)(t0 + r32) * 128 + h * 16; int* ep = (int*)(ws + WS_EXP) + (size_t)(t0 + r32) * 128 + h * 16;
#pragma unroll
                for (int i = 0; i < 4; ++i) {
                    *(f32x4*)(gp + 4 * i) = (f32x4){gsc[4 * i] * rsm, gsc[4 * i + 1] * rsm, gsc[4 * i + 2] * rsm, gsc[4 * i + 3] * rsm};
                    *(u32x4*)(ep + 4 * i) = (u32x4){(unsigned)eid[4 * i], (unsigned)eid[4 * i + 1], (unsigned)eid[4 * i + 2], (unsigned)eid[4 * i + 3]};
                }
            }
        }
        __syncthreads();
    }
}

__device__ __forceinline__ unsigned xcc_id_now() { return (unsigned)__builtin_amdgcn_s_getreg((3 << 11) | 20) & 7u; }
__device__ __forceinline__ int q_next(unsigned* qcnt, int p, LAS int* slot) {
    __syncthreads();
    if (threadIdx.x == 0) *slot = (int)__hip_atomic_fetch_add(qcnt + 64 * p, 1u, __ATOMIC_RELAXED, __HIP_MEMORY_SCOPE_AGENT);
    __syncthreads();
    return *slot;
}
__device__ __forceinline__ int row16_sum_i(int x) {
    x += __builtin_amdgcn_update_dpp(0, x, 0xB1, 0xF, 0xF, true);
    x += __builtin_amdgcn_update_dpp(0, x, 0x4E, 0xF, 0xF, true);
    x += __builtin_amdgcn_update_dpp(0, x, 0x141, 0xF, 0xF, true);
    x += __builtin_amdgcn_update_dpp(0, x, 0x140, 0xF, 0xF, true);
    return x;
}
__device__ __forceinline__ void p7b_udots(const Ctx& C, const Args& a) {
    unsigned char* ws = a.ws;
    const int lane = C.lane, wid = C.wave, sub = lane & 15, tg = lane >> 4;
    unsigned* qcnt = (unsigned*)(ws + WS_QCNT);
    LAS int* slot = (LAS int*)(C.lds + 1024);
    LAS unsigned char* wl = C.lds + 2048 + wid * 12800;
    LAS unsigned* lst = (LAS unsigned*)wl; LAS float* lgt = (LAS float*)(wl + 2048); LAS u32x4* xs = (LAS u32x4*)(wl + 4096); LAS float* sxs = (LAS float*)(wl + 12288);
    const float* SU = (const float*)(ws + WS_SCL); const float* SV = SU + PK * PK;
    const unsigned x0 = xcc_id_now();
    for (int r = 0; r < 8; ++r) {
        const int p = (int)((x0 + r) & 7u);
        for (;;) {
            const int ch = q_next(qcnt, p, slot);
            if (ch >= T / 32) break;
            const int t0w = ch * 32 + wid * 4, t = t0w + tg;
            {
                const unsigned char* xr = ws + WS_X8 + (size_t)t * D + sub * 16;
#pragma unroll
                for (int j = 0; j < 8; ++j) xs[(tg * 8 + j) * 16 + sub] = *(const u32x4*)(xr + 256 * j);
                if (sub == 0) sxs[tg] = ((const float*)(ws + WS_SX))[t];
            }
            int ntot;
            {
                const int* er = (const int*)(ws + WS_EXP) + (size_t)t * 128 + 8 * sub; const float* gr = (const float*)(ws + WS_GATE) + (size_t)t * 128 + 8 * sub;
                const u32x4 e0 = *(const u32x4*)er, e1 = *(const u32x4*)(er + 4); const f32x4 g0 = *(const f32x4*)gr, g1 = *(const f32x4*)(gr + 4);
                const unsigned ev[8] = {e0.x, e0.y, e0.z, e0.w, e1.x, e1.y, e1.z, e1.w}; const float gv[8] = {g0.x, g0.y, g0.z, g0.w, g1.x, g1.y, g1.z, g1.w};
                const unsigned long long lanes_below = (1ull << lane) - 1ull;
                int pos = 0;
#pragma unroll
                for (int i = 0; i < 8; ++i) {
                    const bool mt = (int)(ev[i] >> 11) == p;
                    const unsigned long long bm = __ballot(mt);
                    if (mt) { const int q = pos + __builtin_popcountll(bm & lanes_below); lst[q] = ((unsigned)tg << 21) | ((unsigned)(8 * sub + i) << 14) | ev[i]; lgt[q] = gv[i]; }
                    pos += __builtin_popcountll(bm);
                }
                ntot = pos;
            }
            asm volatile("s_waitcnt lgkmcnt(0)" ::: "memory");
            for (int it = 0; it < ntot; it += 8) {
                const int i0 = it + tg, i1 = it + 4 + tg;
                const unsigned en0 = lst[i0 < ntot ? i0 : ntot - 1], en1 = lst[i1 < ntot ? i1 : ntot - 1];
                const int ea = (int)(en0 & 0x3FFFu), eb = (int)(en1 & 0x3FFFu), ta = (int)(en0 >> 21), tb = (int)(en1 >> 21);
                const unsigned char* ua = ws + WS_UB + (size_t)ea * D + sub * 16; const unsigned char* ub = ws + WS_UB + (size_t)eb * D + sub * 16;
                u32x4 ra[8], rb[8];
#pragma unroll
                for (int j = 0; j < 8; ++j) { ra[j] = *(const u32x4*)(ua + 256 * j); rb[j] = *(const u32x4*)(ub + 256 * j); }
                const float sua = SU[ea] * sxs[ta], sva = SV[ea], sub_ = SU[eb] * sxs[tb], svb = SV[eb];
                const float ga = lgt[i0 < ntot ? i0 : ntot - 1], gb = lgt[i1 < ntot ? i1 : ntot - 1];
                int da = 0, db = 0;
#pragma unroll
                for (int j = 0; j < 8; ++j) {
                    const u32x4 xa = xs[(ta * 8 + j) * 16 + sub], xb = xs[(tb * 8 + j) * 16 + sub];
                    da = __builtin_amdgcn_sdot4((int)ra[j].x, (int)xa.x, da, false); da = __builtin_amdgcn_sdot4((int)ra[j].y, (int)xa.y, da, false);
                    da = __builtin_amdgcn_sdot4((int)ra[j].z, (int)xa.z, da, false); da = __builtin_amdgcn_sdot4((int)ra[j].w, (int)xa.w, da, false);
                    db = __builtin_amdgcn_sdot4((int)rb[j].x, (int)xb.x, db, false); db = __builtin_amdgcn_sdot4((int)rb[j].y, (int)xb.y, db, false);
                    db = __builtin_amdgcn_sdot4((int)rb[j].z, (int)xb.z, db, false); db = __builtin_amdgcn_sdot4((int)rb[j].w, (int)xb.w, db, false);
                }
                da = row16_sum_i(da); db = row16_sum_i(db);
                const float ca = ga * gelu_tanh_f((float)da * sua) * sva, cb = gb * gelu_tanh_f((float)db * sub_) * svb;
                if (sub == 0) {
                    if (i0 < ntot) ((float*)(ws + WS_CP))[(size_t)(t0w + ta) * 128 + ((en0 >> 14) & 127u)] = ca;
                    if (i1 < ntot) ((float*)(ws + WS_CP))[(size_t)(t0w + tb) * 128 + ((en1 >> 14) & 127u)] = cb;
                }
            }
        }
    }
}
__device__ __forceinline__ void p7c_vacc(const Ctx& C, const Args& a) {
    unsigned char* ws = a.ws;
    const int lane = C.lane, wid = C.wave, sub = lane & 15, tg = lane >> 4;
    unsigned* qcnt = (unsigned*)(ws + WS_QCNT) + 64 * 8;
    LAS int* slot = (LAS int*)(C.lds + 1024);
    LAS int* lex = (LAS int*)(C.lds + 2048) + wid * 512 + tg * 128;
    LAS unsigned* lcq = (LAS unsigned*)(C.lds + 2048 + 16384) + wid * 128 + tg * 32;
    const unsigned x0 = xcc_id_now();
    for (int r = 0; r < 8; ++r) {
        const int p = (int)((x0 + r) & 7u);
        for (;;) {
            const int ch = q_next(qcnt, p, slot);
            if (ch >= T / 32) break;
            const int t = ch * 32 + wid * 4 + tg;
            const f32x4 c0 = *(const f32x4*)((const float*)(ws + WS_CP) + (size_t)t * 128 + 8 * sub), c1 = *(const f32x4*)((const float*)(ws + WS_CP) + (size_t)t * 128 + 8 * sub + 4);
            float mx = fmaxf(fmaxf(fmaxf(fabsf(c0.x), fabsf(c0.y)), fmaxf(fabsf(c0.z), fabsf(c0.w))), fmaxf(fmaxf(fabsf(c1.x), fabsf(c1.y)), fmaxf(fabsf(c1.z), fabsf(c1.w))));
#pragma unroll
            for (int o = 1; o < 16; o <<= 1) mx = fmaxf(mx, __shfl_xor(mx, o));
            const float inv = mx > 0.f ? 127.0f / mx : 0.f, sc8 = mx * (1.0f / 127.0f);
#define Q8C(v) ((int)rintf((v) * inv))
            const int q0 = Q8C(c0.x), q1 = Q8C(c0.y), q2 = Q8C(c0.z), q3 = Q8C(c0.w), q4 = Q8C(c1.x), q5 = Q8C(c1.y), q6 = Q8C(c1.z), q7 = Q8C(c1.w);
#undef Q8C
            lcq[2 * sub] = ((unsigned)q0 & 0xffu) | (((unsigned)q1 & 0xffu) << 8) | (((unsigned)q2 & 0xffu) << 16) | (((unsigned)q3 & 0xffu) << 24);
            lcq[2 * sub + 1] = ((unsigned)q4 & 0xffu) | (((unsigned)q5 & 0xffu) << 8) | (((unsigned)q6 & 0xffu) << 16) | (((unsigned)q7 & 0xffu) << 24);
            int sq = (abs(q0) + abs(q1)) + (abs(q2) + abs(q3)) + (abs(q4) + abs(q5)) + (abs(q6) + abs(q7));
            sq = row16_sum_i(sq);
            const float bnd = ((const float*)(ws + WS_AMAX1))[t] + sc8 * (127.0f * (float)sq);
            const float invh = bnd > 0.f ? 127.0f / bnd : 0.f;
            if (p == 0 && sub == 0) ((float*)(ws + WS_SAH2))[t] = bnd * (1.0f / 127.0f);
            { const int* er = (const int*)(ws + WS_EXP) + (size_t)t * 128 + 8 * sub; const u32x4 e0 = *(const u32x4*)er, e1 = *(const u32x4*)(er + 4);
              *(LAS u32x4*)(lex + 8 * sub) = e0; *(LAS u32x4*)(lex + 8 * sub + 4) = e1; }
            asm volatile("s_waitcnt lgkmcnt(0)" ::: "memory");
            const unsigned char* vb = ws + WS_VB + (size_t)p * ((size_t)PK * PK * 256) + 16 * sub;
            int oacc[16];
#pragma unroll
            for (int i = 0; i < 16; ++i) oacc[i] = 0;
#pragma unroll 2
            for (int g4 = 0; g4 < 32; ++g4) {
                const u32x4 e4 = *(const LAS u32x4*)(lex + 4 * g4);
                const int cw = (int)lcq[g4];
                const u32x4 r0 = *(const u32x4*)(vb + (size_t)e4.x * 256), r1 = *(const u32x4*)(vb + (size_t)e4.y * 256), r2 = *(const u32x4*)(vb + (size_t)e4.z * 256), r3 = *(const u32x4*)(vb + (size_t)e4.w * 256);
#define QUADW(W, idx) do { const unsigned ablo = __builtin_amdgcn_perm(r1.W, r0.W, 0x05010400u), abhi = __builtin_amdgcn_perm(r1.W, r0.W, 0x07030602u); \
                    const unsigned cdlo = __builtin_amdgcn_perm(r3.W, r2.W, 0x05010400u), cdhi = __builtin_amdgcn_perm(r3.W, r2.W, 0x07030602u); \
                    oacc[4 * (idx) + 0] = __builtin_amdgcn_sdot4((int)__builtin_amdgcn_perm(cdlo, ablo, 0x05040100u), cw, oacc[4 * (idx) + 0], false); \
                    oacc[4 * (idx) + 1] = __builtin_amdgcn_sdot4((int)__builtin_amdgcn_perm(cdlo, ablo, 0x07060302u), cw, oacc[4 * (idx) + 1], false); \
                    oacc[4 * (idx) + 2] = __builtin_amdgcn_sdot4((int)__builtin_amdgcn_perm(cdhi, abhi, 0x05040100u), cw, oacc[4 * (idx) + 2], false); \
                    oacc[4 * (idx) + 3] = __builtin_amdgcn_sdot4((int)__builtin_amdgcn_perm(cdhi, abhi, 0x07060302u), cw, oacc[4 * (idx) + 3], false); } while (0)
                QUADW(x, 0); QUADW(y, 1); QUADW(z, 2); QUADW(w, 3);
#undef QUADW
            }
            const size_t off = (size_t)t * D + 256 * p + 16 * sub;
            const bf16_t* h1r = (const bf16_t*)(ws + WS_H1B) + off; bf16_t* h2b = (bf16_t*)(ws + WS_XB) + off;
            const u32x4 hw0 = *(const u32x4*)h1r, hw1 = *(const u32x4*)(h1r + 8);
            const unsigned hw[8] = {hw0.x, hw0.y, hw0.z, hw0.w, hw1.x, hw1.y, hw1.z, hw1.w};
            float s3 = 0.f; unsigned ow[8]; unsigned qb[16];
#pragma unroll
            for (int q = 0; q < 8; ++q) {
                const float y0 = __builtin_bit_cast(float, hw[q] << 16) + sc8 * (float)oacc[2 * q], y1 = __builtin_bit_cast(float, hw[q] & 0xffff0000u) + sc8 * (float)oacc[2 * q + 1];
                s3 += y0 * y0 + y1 * y1; ow[q] = pk2(y0, y1);
                qb[2 * q] = (unsigned)(int)rintf(y0 * invh) & 0xffu; qb[2 * q + 1] = (unsigned)(int)rintf(y1 * invh) & 0xffu;
            }
            { u32x4 qv; qv.x = qb[0] | (qb[1] << 8) | (qb[2] << 16) | (qb[3] << 24); qv.y = qb[4] | (qb[5] << 8) | (qb[6] << 16) | (qb[7] << 24);
              qv.z = qb[8] | (qb[9] << 8) | (qb[10] << 16) | (qb[11] << 24); qv.w = qb[12] | (qb[13] << 8) | (qb[14] << 16) | (qb[15] << 24);
              *(u32x4*)(ws + WS_H2Q + off) = qv; }
            { u32x4 w0 = {ow[0], ow[1], ow[2], ow[3]}, w1 = {ow[4], ow[5], ow[6], ow[7]}; *(u32x4*)h2b = w0; *(u32x4*)(h2b + 8) = w1; }
#pragma unroll
            for (int o = 1; o < 16; o <<= 1) s3 += __shfl_xor(s3, o);
            if (sub == 0) ((float*)(ws + WS_SSQP))[(size_t)t * 8 + p] = s3;
        }
    }
}
__device__ __noinline__ void grid_sync_all() { cg::this_grid().sync(); }
__device__ __forceinline__ bool phase_ctx(Ctx& C) { int t_ = threadIdx.x; asm volatile("" : "+v"(t_)); C.tid = t_; C.lane = t_ & 63; return true; }
template <int PH_MASK>
__global__ void __launch_bounds__(NTHR, 2) fwd(Args a) {
    extern __shared__ __attribute__((aligned(16))) unsigned char lds_raw[];
    Ctx C;
    C.tid = threadIdx.x; C.lane = C.tid & 63; C.wave = __builtin_amdgcn_readfirstlane(C.tid >> 6);
    C.G = gridDim.x; C.bid = blockIdx.x;
    C.vcu = (C.G % 8 == 0) ? (C.bid % 8) * (C.G / 8) + C.bid / 8 : C.bid;
    C.lds = (LAS unsigned char*)lds_raw;
    volatile LAS unsigned* bst = (volatile LAS unsigned*)(C.lds + LDS_BYTES - 64);
    if (C.tid < 2) bst[C.tid] = 0u;
    unsigned* barw = (unsigned*)(a.ws + WS_BAR);
    __syncthreads();
    const XcdBarrier xbar = xcd_barrier_post(barw, bst);
    if (a.ph_lo < 0) grid_sync_all();
#define IN(k) (((PH_MASK >> (k)) & 1) && a.ph_lo <= (k) && (k) < a.ph_hi && phase_ctx(C))
#define SEAM(k) do { if (IN(k) && IN((k) + 1)) xcd_barrier(xbar); } while (0)
    if (IN(0)) p0_prologue(C, a);
    SEAM(0);
    if (IN(1)) p1_inproj(C, a);
#ifdef SPLIT_INDEXER
    if (IN(2)) p2_scores(C, a);
    SEAM(2);
    if (IN(3)) p3_select(C, a);
    SEAM(3);
#else
    if (IN(2)) p23_index_select<((PH_MASK >> 1) & 1) != 0>(C, a);
    SEAM(2);
#endif
    if (IN(4)) p4_attention(C, a, (char*)lds_raw);
    SEAM(4);
    if (IN(5)) p5_outproj(C, a);
    SEAM(5);
    const bool rt_tile = (C.G == 256) && IN(6) && IN(7);
    if (IN(6)) {
        p5b_tokprep(C, a); xcd_barrier(xbar);
        p6_peerq_pp(C, a, false);
        if (rt_tile) {
            asm volatile("s_waitcnt vmcnt(0)" ::: "memory");
            const int w_ = (C.bid % 8) * 32 + C.bid / 8, in_ = w_ % 64;
            p7a_route(C, a, true, (w_ / 64) * 8 + in_ % 8, in_ / 8);
        }
        p6_peerq_pp(C, a, true);
    }
    if (!rt_tile) { SEAM(6); if (IN(7)) p7a_route(C, a, false, 0, 0); }
    SEAM(7);
    if (IN(8)) p7b_udots(C, a);
    SEAM(8);
    if (IN(9)) p7c_vacc(C, a);
    SEAM(9);
    if (IN(10)) p8_ple(C, a);
#undef IN
#undef SEAM
}

#ifndef REPEAT_PHASE
#define REPEAT_PHASE (-1)
#endif
template <int PH_MASK = 0x7FF>
inline void launch(void* const* d_in, void* d_out, void* d_ws, int lo, int hi, hipStream_t st) {
    static int grid = 0;
    if (!grid) {
        int dev = 0, cus = 0, per_cu = 0;
        hipGetDevice(&dev);
        hipDeviceGetAttribute(&cus, hipDeviceAttributeMultiprocessorCount, dev);
        hipFuncSetAttribute((const void*)fwd<PH_MASK>, hipFuncAttributeMaxDynamicSharedMemorySize, LDS_BYTES);
        hipOccupancyMaxActiveBlocksPerMultiprocessor(&per_cu, (const void*)fwd<PH_MASK>, NTHR, LDS_BYTES);
        if (per_cu < 1) fprintf(stderr, "fwd: occupancy query says %d blocks/CU\n", per_cu);
        grid = cus;
    }
    if (hipMemsetAsync((char*)d_ws + WS_BAR, 0, WS_CTL_BYTES, st) != hipSuccess) fprintf(stderr, "hipMemsetAsync of the control words failed\n");
    Args a{};
    for (int i = 0; i < 17; ++i) a.in[i] = (const float*)d_in[i];
    a.out = (float*)d_out; a.ws = (unsigned char*)d_ws; a.ph_lo = lo; a.ph_hi = hi; a.rep_phase = REPEAT_PHASE; a.pad = 0;
    void* args[] = {&a};
    hipError_t e = hipLaunchCooperativeKernel((const void*)fwd<PH_MASK>, dim3(grid), dim3(NTHR), args, LDS_BYTES, st);
    if (e != hipSuccess) fprintf(stderr, "cooperative launch failed: %s (grid %d)\n", hipGetErrorString(e), grid);
}
}
namespace fk {
__global__ __launch_bounds__(256) void k_adapt_proj(const unsigned char* ws, long delta, float* proj) {
    ws += delta;
    const int t = blockIdx.x;
    float* row = proj + (size_t)t * NPROJ;
    const size_t offs[7] = {WS_QA, WS_KA, WS_VA, WS_QB, WS_KB, WS_VBB, WS_QI};
    for (int i = threadIdx.x; i < 7168; i += 256) {
        const int seg = i >> 10, c = i & 1023;
        row[i] = bf2f(((const bf16_t*)(ws + offs[seg]))[(size_t)t * 1024 + c]);
    }
    if (threadIdx.x < 64) row[7168 + threadIdx.x] = bf2f(((const bf16_t*)(ws + WS_KI))[(size_t)t * 64 + threadIdx.x]);
    if (threadIdx.x < 16) row[7232 + threadIdx.x] = ((const float*)(ws + WS_WI))[(size_t)t * 16 + threadIdx.x] * 32.0f;
}
__global__ __launch_bounds__(256) void k_adapt_att(const bf16_t* o, float* att, size_t n) {
    for (size_t i = (size_t)blockIdx.x * 256 + threadIdx.x; i < n; i += (size_t)gridDim.x * 256) att[i] = bf2f(o[i]);
}
}
namespace fk {
__global__ __launch_bounds__(256) void k_adapt_qv(const bf16_t* qv, const float* h1, float* out) {
    __shared__ float red[4];
    const int t = blockIdx.x, tid = threadIdx.x;
    float s = 0.f;
    for (int i = tid; i < 2048; i += 256) { const float v = h1[(size_t)t * 2048 + i]; s += v * v; }
    s = wave_sum(s);
    if ((tid & 63) == 0) red[tid >> 6] = s;
    __syncthreads();
    const float rs2 = rsqrtf((red[0] + red[1] + red[2] + red[3]) * (1.0f / 2048.f) + 1e-6f);
    for (int i = tid; i < 2048; i += 256) out[(size_t)t * 2048 + i] = bf2f(qv[(size_t)t * 2048 + i]) * rs2;
}
}
extern "C" void kernel_launch(void* const* d_in, const int* in_sizes, int n_in, void* d_out, int out_size, void* d_ws, size_t ws_size, hipStream_t stream) {
    if (n_in != 17 || out_size != cfg::T * cfg::D || ws_size < fk::WS_END) {
        fprintf(stderr, "kernel_launch: unexpected shapes n_in=%d out=%d ws=%zu\n", n_in, out_size, ws_size);
        return;
    }
    fk::launch(d_in, d_out, d_ws, 0, 11, stream);
}
```

```cpp
#include <hip/hip_runtime.h>
#include <cstdio>
#include <cstdint>
#include <cmath>

namespace cfg {
constexpr int B = 2, S = 4096, T = B * S, D = 2048, CH = 64, HD = 128, NHA = 8, NHB = 8, LEFT = 8, BAND = 576, MAXREL = 128;
constexpr int IH = 16, ID = 64, TOPK = 256, PH = 8, PK = 128, PQD = 256, PTOP = 16, PLE = 256, NPROJ = 7248;
constexpr int OFF_QA = 0, OFF_KA = 1024, OFF_VA = 2048, OFF_QB = 3072, OFF_KB = 4096, OFF_VB = 5120, OFF_QI = 6144, OFF_KI = 7168, OFF_WI = 7232;
constexpr float EPS = 1e-6f;
}
namespace nv {
using namespace cfg;
#ifndef NAIVE_RB
#define NAIVE_RB 0
#endif

__device__ __forceinline__ float wsum(float v) {
#pragma unroll
    for (int o = 32; o > 0; o >>= 1) v += __shfl_xor(v, o);
    return v;
}
__device__ __forceinline__ float wmax(float v) {
#pragma unroll
    for (int o = 32; o > 0; o >>= 1) v = fmaxf(v, __shfl_xor(v, o));
    return v;
}
__device__ __forceinline__ int wsumi(int v) {
#pragma unroll
    for (int o = 32; o > 0; o >>= 1) v += __shfl_xor(v, o);
    return v;
}
__device__ __forceinline__ unsigned skey(float f) {
    unsigned u = __float_as_uint(f);
    return (u & 0x80000000u) ? ~u : (u | 0x80000000u);
}

__device__ __forceinline__ float rbf(float f) { unsigned u = __float_as_uint(f); u = (u + 0x7fffu + ((u >> 16) & 1u)) & 0xffff0000u; return __uint_as_float(u); }
__global__ __launch_bounds__(256) void k_rmsnorm(const float* __restrict__ x, const float* __restrict__ g, float* __restrict__ y) {
    __shared__ float red[4];
    const int row = blockIdx.x, tid = threadIdx.x;
    const float4* xr = (const float4*)(x + (size_t)row * D);
    float4 a = xr[tid], b = xr[tid + 256];
    float s = a.x * a.x + a.y * a.y + a.z * a.z + a.w * a.w + b.x * b.x + b.y * b.y + b.z * b.z + b.w * b.w;
    s = wsum(s);
    if ((tid & 63) == 0) red[tid >> 6] = s;
    __syncthreads();
    const float tot = red[0] + red[1] + red[2] + red[3];
    const float sc = rsqrtf(tot * (1.0f / D) + EPS);
    const float4 ga = ((const float4*)g)[tid], gb = ((const float4*)g)[tid + 256];
    float4* yr = (float4*)(y + (size_t)row * D);
    yr[tid] = make_float4(a.x * sc * ga.x, a.y * sc * ga.y, a.z * sc * ga.z, a.w * sc * ga.w);
    yr[tid + 256] = make_float4(b.x * sc * gb.x, b.y * sc * gb.y, b.z * sc * gb.z, b.w * sc * gb.w);
}

template <bool ADD, bool RB = false>
__global__ __launch_bounds__(256) void k_sgemm(const float* __restrict__ A, const float* __restrict__ Bm, float* __restrict__ C,
                                               const float* __restrict__ R, int M, int N, int K) {
    __shared__ float As[8][132];
    __shared__ float Bs[8][132];
    const int tid = threadIdx.x, tx = tid & 15, ty = tid >> 4;
    const int m0 = blockIdx.y * 128, n0 = blockIdx.x * 128;
    float acc[8][8];
#pragma unroll
    for (int i = 0; i < 8; ++i)
#pragma unroll
        for (int j = 0; j < 8; ++j) acc[i][j] = 0.f;
    const int a_row = tid >> 1, a_k = (tid & 1) * 4;
    const int b_k = tid >> 5, b_n = (tid & 31) * 4;
    for (int k0 = 0; k0 < K; k0 += 8) {
        float4 av = *(const float4*)(A + (size_t)(m0 + a_row) * K + k0 + a_k);
        float4 bv = make_float4(0.f, 0.f, 0.f, 0.f);
        if (n0 + b_n < N) bv = *(const float4*)(Bm + (size_t)(k0 + b_k) * N + n0 + b_n);
        if (RB) { av.x = rbf(av.x); av.y = rbf(av.y); av.z = rbf(av.z); av.w = rbf(av.w); bv.x = rbf(bv.x); bv.y = rbf(bv.y); bv.z = rbf(bv.z); bv.w = rbf(bv.w); }
        __syncthreads();
        As[a_k + 0][a_row] = av.x; As[a_k + 1][a_row] = av.y; As[a_k + 2][a_row] = av.z; As[a_k + 3][a_row] = av.w;
        *(float4*)&Bs[b_k][b_n] = bv;
        __syncthreads();
#pragma unroll
        for (int kk = 0; kk < 8; ++kk) {
            const float4 a0 = *(const float4*)&As[kk][ty * 8], a1 = *(const float4*)&As[kk][ty * 8 + 4];
            const float4 b0 = *(const float4*)&Bs[kk][tx * 8], b1 = *(const float4*)&Bs[kk][tx * 8 + 4];
            const float a[8] = {a0.x, a0.y, a0.z, a0.w, a1.x, a1.y, a1.z, a1.w};
            const float b[8] = {b0.x, b0.y, b0.z, b0.w, b1.x, b1.y, b1.z, b1.w};
#pragma unroll
            for (int i = 0; i < 8; ++i)
#pragma unroll
                for (int j = 0; j < 8; ++j) acc[i][j] = fmaf(a[i], b[j], acc[i][j]);
        }
    }
#pragma unroll
    for (int i = 0; i < 8; ++i) {
        const size_t ro = (size_t)(m0 + ty * 8 + i) * N;
#pragma unroll
        for (int jj = 0; jj < 2; ++jj) {
            const int col = n0 + tx * 8 + jj * 4;
            if (col < N) {
                float4 v = make_float4(acc[i][jj * 4 + 0], acc[i][jj * 4 + 1], acc[i][jj * 4 + 2], acc[i][jj * 4 + 3]);
                if (ADD) { const float4 r = *(const float4*)(R + ro + col); v.x += r.x; v.y += r.y; v.z += r.z; v.w += r.w; }
                *(float4*)(C + ro + col) = v;
            }
        }
    }
}

template <bool RB>
__global__ __launch_bounds__(256) void k_postproj(float* __restrict__ proj, const int* __restrict__ positions,
                                                  const float* __restrict__ gqa  , const float* __restrict__ gqb  ) {
    const int t = blockIdx.x, tid = threadIdx.x, wave = tid >> 6, lane = tid & 63;
    float* row = proj + (size_t)t * NPROJ;
    const double pos = (double)positions[t];
    for (int u = wave; u < 48; u += 4) {
        const int grp = u >> 3;
        if (grp == 2 || grp == 5) { if (RB) { float* hp = row + u * 128; hp[lane] = rbf(hp[lane]); hp[lane + 64] = rbf(hp[lane + 64]); } continue; }
        float* hp = row + u * 128;
        float v0 = hp[lane], v1 = hp[lane + 64];
        const float ssq = wsum(v0 * v0 + v1 * v1);
        const float sc = rsqrtf(ssq * (1.0f / 128.f) + EPS);
        const float* g = (grp == 0) ? gqa : (grp == 1) ? gqa + 128 : (grp == 3) ? gqb : gqb + 128;
        v0 = v0 * sc * g[lane]; v1 = v1 * sc * g[lane + 64];
        if (grp >= 3) {
            const float partner = __shfl_xor(v0, 16);
            if (lane < 32) {
                const int i = lane & 15;
                const double inv = exp(-log(500000.0) * (double)i / 16.0);
                const double ang = pos * inv;
                const float cs = (float)cos(ang), sn = (float)sin(ang);
                v0 = (lane < 16) ? (v0 * cs - partner * sn) : (v0 * cs + partner * sn);
            }
        }
        if (RB) { v0 = rbf(v0); v1 = rbf(v1); }
        hp[lane] = v0; hp[lane + 64] = v1;
    }
    for (int u = wave; u < 17; u += 4) {
        float* hp = row + OFF_QI + u * 64;
        float v = hp[lane];
        const float partner = __shfl_xor(v, 8);
        if (lane < 16) {
            const int i = lane & 7;
            const double inv = exp(-log(500000.0) * (double)i / 8.0);
            const double ang = pos * inv;
            const float cs = (float)cos(ang), sn = (float)sin(ang);
            v = (lane < 8) ? (v * cs - partner * sn) : (v * cs + partner * sn);
        }
        if (RB) v = rbf(v);
        hp[lane] = v;
    }
}

__global__ __launch_bounds__(256) void k_mixa(const float* __restrict__ proj, const float* __restrict__ rel_bias  , float* __restrict__ out  ) {
    __shared__ float qs[4][128];
    __shared__ float ps[4][BAND];
    const int tid = threadIdx.x, wave = tid >> 6, lane = tid & 63;
    const int gid = blockIdx.x * 4 + wave;
    const int t = gid >> 3, h = gid & 7;
    const int b = t / S, s = t % S, c = s / CH, qi = s % CH;
    const float* qrow = proj + (size_t)t * NPROJ + OFF_QA + h * 128;
    qs[wave][lane] = qrow[lane]; qs[wave][lane + 64] = qrow[lane + 64];
    __syncthreads();
    float sc[9];
    float mx = -INFINITY;
#pragma unroll
    for (int i = 0; i < 9; ++i) {
        const int kj = lane + 64 * i;
        const int kp = (c - LEFT) * CH + kj;
        float v = -INFINITY;
        if (kp >= 0) {
            const float4* kr = (const float4*)(proj + (size_t)(b * S + kp) * NPROJ + OFF_KA + h * 128);
            float d = 0.f;
#pragma unroll 8
            for (int j = 0; j < 32; ++j) { const float4 kv = kr[j]; const float4 qv = *(const float4*)&qs[wave][j * 4]; d += kv.x * qv.x + kv.y * qv.y + kv.z * qv.z + kv.w * qv.w; }
            int dist = qi + LEFT * CH - kj;
            dist = dist < -MAXREL ? -MAXREL : (dist > MAXREL ? MAXREL : dist);
            v = d * 0.08838834764831845f + rel_bias[h * 257 + dist + MAXREL];
        }
        sc[i] = v; mx = fmaxf(mx, v);
    }
    mx = wmax(mx);
    float sum = 0.f;
#pragma unroll
    for (int i = 0; i < 9; ++i) { const float p = (sc[i] == -INFINITY) ? 0.f : expf(sc[i] - mx); sum += p; ps[wave][lane + 64 * i] = p; }
    sum = wsum(sum);
    __syncthreads();
    float a0 = 0.f, a1 = 0.f;
    for (int kj = 0; kj < BAND; ++kj) {
        const int kp = (c - LEFT) * CH + kj;
        if (kp < 0) continue;
        const float p = ps[wave][kj];
        const float* vr = proj + (size_t)(b * S + kp) * NPROJ + OFF_VA + h * 128;
        a0 += p * vr[lane]; a1 += p * vr[lane + 64];
    }
    const float inv = 1.0f / sum;
    out[(size_t)t * 2048 + h * 128 + lane] = a0 * inv;
    out[(size_t)t * 2048 + h * 128 + lane + 64] = a1 * inv;
}

__global__ __launch_bounds__(256) void k_dsa(const float* __restrict__ proj, float* __restrict__ out) {
    __shared__ float sc[4096];
    __shared__ float lg[4096];
    __shared__ float qis[16 * 64];
    __shared__ float wis[16];
    __shared__ float qh[128];
    __shared__ float redf[4];
    __shared__ int redi[4];
    __shared__ float acc2[256];
    const int t = blockIdx.x, tid = threadIdx.x, wave = tid >> 6, lane = tid & 63;
    const int b = t / S, s = t % S, c = s / CH;
    const int nadm = (c + 1) * CH;
    const float* prow = proj + (size_t)t * NPROJ;
    for (int i = tid; i < 1024; i += 256) qis[i] = prow[OFF_QI + i];
    if (tid < 16) wis[tid] = prow[OFF_WI + tid] * 0.25f;
    __syncthreads();
    for (int kp = tid; kp < nadm; kp += 256) {
        const float4* kr = (const float4*)(proj + (size_t)(b * S + kp) * NPROJ + OFF_KI);
        float4 k[16];
#pragma unroll
        for (int j = 0; j < 16; ++j) k[j] = kr[j];
        float score = 0.f;
        for (int h = 0; h < 16; ++h) {
            float d = 0.f;
#pragma unroll
            for (int j = 0; j < 16; ++j) { const float4 qv = *(const float4*)&qis[h * 64 + j * 4]; d += qv.x * k[j].x + qv.y * k[j].y + qv.z * k[j].z + qv.w * k[j].w; }
            score += wis[h] * fmaxf(d * 0.125f, 0.f);
        }
        sc[kp] = score;
    }
    __syncthreads();
    unsigned thr = 0u;
    if (nadm > TOPK) {
        for (int bit = 31; bit >= 0; --bit) {
            const unsigned cand = thr | (1u << bit);
            int local = 0;
            for (int kp = tid; kp < nadm; kp += 256) local += (skey(sc[kp]) >= cand) ? 1 : 0;
            local = wsumi(local);
            if (lane == 0) redi[wave] = local;
            __syncthreads();
            const int tot = redi[0] + redi[1] + redi[2] + redi[3];
            __syncthreads();
            if (tot >= TOPK) thr = cand;
        }
    }
    for (int h = 0; h < 8; ++h) {
        if (tid < 128) qh[tid] = prow[OFF_QB + h * 128 + tid];
        __syncthreads();
        float lmax = -INFINITY;
        for (int kp = tid; kp < nadm; kp += 256) {
            float l = -INFINITY;
            if (skey(sc[kp]) >= thr) {
                const float4* kr = (const float4*)(proj + (size_t)(b * S + kp) * NPROJ + OFF_KB + h * 128);
                float d = 0.f;
#pragma unroll 8
                for (int j = 0; j < 32; ++j) { const float4 kv = kr[j]; const float4 qv = *(const float4*)&qh[j * 4]; d += kv.x * qv.x + kv.y * qv.y + kv.z * qv.z + kv.w * qv.w; }
                l = d * 0.08838834764831845f;
            }
            lg[kp] = l; lmax = fmaxf(lmax, l);
        }
        lmax = wmax(lmax);
        if (lane == 0) redf[wave] = lmax;
        __syncthreads();
        const float m = fmaxf(fmaxf(redf[0], redf[1]), fmaxf(redf[2], redf[3]));
        __syncthreads();
        float lsum = 0.f;
        for (int kp = tid; kp < nadm; kp += 256) { const float l = lg[kp]; const float p = (l == -INFINITY) ? 0.f : expf(l - m); lg[kp] = p; lsum += p; }
        lsum = wsum(lsum);
        if (lane == 0) redf[wave] = lsum;
        __syncthreads();
        const float L = redf[0] + redf[1] + redf[2] + redf[3];
        const int d = tid & 127, half = tid >> 7;
        float a = 0.f;
        for (int kp = half; kp < nadm; kp += 2) {
            const float p = lg[kp];
            if (p != 0.f) a += p * proj[(size_t)(b * S + kp) * NPROJ + OFF_VB + h * 128 + d];
        }
        acc2[tid] = a;
        __syncthreads();
        if (tid < 128) out[(size_t)t * 2048 + 1024 + h * 128 + tid] = (acc2[tid] + acc2[tid + 128]) / L;
        __syncthreads();
    }
}

__global__ __launch_bounds__(256) void k_peer_route(const float* __restrict__ qv  , const float* __restrict__ subk  ,
                                                    int* __restrict__ expert, float* __restrict__ gate, unsigned* dbg_lists = nullptr) {
    __shared__ float qs[4][256];
    __shared__ float tv[4][2][16];
    __shared__ int ti[4][2][16];
    const int tid = threadIdx.x, wave = tid >> 6, lane = tid & 63;
    const int gid = blockIdx.x * 4 + wave;
    const int t = gid >> 3, h = gid & 7;
    const float* q = qv + (size_t)t * 2048 + h * 256;
#pragma unroll
    for (int j = 0; j < 4; ++j) qs[wave][lane + 64 * j] = q[lane + 64 * j];
    __syncthreads();
    for (int half = 0; half < 2; ++half) {
        float sv[2];
#pragma unroll
        for (int r = 0; r < 2; ++r) {
            const int n = lane + 64 * r;
            const float4* kr = (const float4*)(subk + ((size_t)half * 128 + n) * 128);
            float d = 0.f;
#pragma unroll 8
            for (int j = 0; j < 32; ++j) { const float4 kv = kr[j]; const float4 qq = *(const float4*)&qs[wave][half * 128 + j * 4]; d += kv.x * qq.x + kv.y * qq.y + kv.z * qq.z + kv.w * qq.w; }
            sv[r] = d;
        }
        for (int it = 0; it < 16; ++it) {
            float bv; int bi;
            if (sv[0] >= sv[1]) { bv = sv[0]; bi = lane; } else { bv = sv[1]; bi = lane + 64; }
#pragma unroll
            for (int o = 32; o > 0; o >>= 1) {
                const float ov = __shfl_xor(bv, o); const int oi = __shfl_xor(bi, o);
                if (ov > bv || (ov == bv && oi < bi)) { bv = ov; bi = oi; }
            }
            if (lane == 0) { tv[wave][half][it] = bv; ti[wave][half][it] = bi; }
            if (bi == lane) sv[0] = -INFINITY;
            if (bi == lane + 64) sv[1] = -INFINITY;
        }
    }
    __syncthreads();
#ifdef NAIVE_EXPORT_LISTS
    if (lane < 32) NAIVE_EXPORT_LISTS[((size_t)t * 8 + h) * 32 + lane] = 127u - (unsigned)ti[wave][lane >> 4][lane & 15];
#endif
    float cv[4];
#pragma unroll
    for (int r = 0; r < 4; ++r) { const int ci = lane * 4 + r; cv[r] = tv[wave][0][ci >> 4] + tv[wave][1][ci & 15]; }
    float scv = 0.f; int sci = 0;
    for (int it = 0; it < 16; ++it) {
        float bv = cv[0]; int bi = lane * 4;
#pragma unroll
        for (int r = 1; r < 4; ++r) if (cv[r] > bv) { bv = cv[r]; bi = lane * 4 + r; }
#pragma unroll
        for (int o = 32; o > 0; o >>= 1) {
            const float ov = __shfl_xor(bv, o); const int oi = __shfl_xor(bi, o);
            if (ov > bv || (ov == bv && oi < bi)) { bv = ov; bi = oi; }
        }
        if (lane == it) { scv = bv; sci = bi; }
#pragma unroll
        for (int r = 0; r < 4; ++r) if (bi == lane * 4 + r) cv[r] = -INFINITY;
    }
    const float mx = __shfl(scv, 0);
    float e = (lane < 16) ? expf(scv - mx) : 0.f;
    const float sum = wsum(e);
    if (lane < 16) {
        const int e1 = ti[wave][0][sci >> 4], e2 = ti[wave][1][sci & 15];
        expert[(size_t)t * 128 + h * 16 + lane] = e1 * 128 + e2;
        gate[(size_t)t * 128 + h * 16 + lane] = e / sum;
    }
}

__device__ __forceinline__ float gelu_tanh(float x) {
    const float u = 0.7978845608028654f * (x + 0.044715f * x * x * x);
    return 0.5f * x * (1.0f + tanhf(u));
}

__global__ __launch_bounds__(256) void k_peer_experts(const float* __restrict__ xn, const int* __restrict__ expert, const float* __restrict__ gate,
                                                      const float* __restrict__ U, const float* __restrict__ V, const float* __restrict__ hin, float* __restrict__ hout) {
    __shared__ float xs[2048];
    __shared__ float coef[128];
    __shared__ int eid[128];
    const int t = blockIdx.x, tid = threadIdx.x, wave = tid >> 6, lane = tid & 63;
    for (int i = tid; i < 2048; i += 256) xs[i] = xn[(size_t)t * 2048 + i];
    if (tid < 128) eid[tid] = expert[(size_t)t * 128 + tid];
    __syncthreads();
    for (int k = wave; k < 128; k += 4) {
        const float4* ur = (const float4*)(U + (size_t)eid[k] * 2048);
        float d = 0.f;
#pragma unroll
        for (int j = 0; j < 8; ++j) { const float4 uv = ur[lane + 64 * j]; const float4 xv = *(const float4*)&xs[(lane + 64 * j) * 4]; d += uv.x * xv.x + uv.y * xv.y + uv.z * xv.z + uv.w * xv.w; }
        d = wsum(d);
        if (lane == 0) coef[k] = gate[(size_t)t * 128 + k] * gelu_tanh(d);
    }
    __syncthreads();
    float4 a0 = make_float4(0.f, 0.f, 0.f, 0.f), a1 = a0;
    for (int k = 0; k < 128; ++k) {
        const float cf = coef[k];
        const float4* vr = (const float4*)(V + (size_t)eid[k] * 2048);
        const float4 v0 = vr[tid], v1 = vr[tid + 256];
        a0.x += cf * v0.x; a0.y += cf * v0.y; a0.z += cf * v0.z; a0.w += cf * v0.w;
        a1.x += cf * v1.x; a1.y += cf * v1.y; a1.z += cf * v1.z; a1.w += cf * v1.w;
    }
    const float4* hi = (const float4*)(hin + (size_t)t * 2048);
    float4* ho = (float4*)(hout + (size_t)t * 2048);
    const float4 h0 = hi[tid], h1 = hi[tid + 256];
    ho[tid] = make_float4(h0.x + a0.x, h0.y + a0.y, h0.z + a0.z, h0.w + a0.w);
    ho[tid + 256] = make_float4(h1.x + a1.x, h1.y + a1.y, h1.z + a1.z, h1.w + a1.w);
}

__global__ __launch_bounds__(256) void k_ple_final(float* __restrict__ out, const float* __restrict__ gp, const float* __restrict__ pp, size_t n4) {
    for (size_t i = (size_t)blockIdx.x * blockDim.x + threadIdx.x; i < n4; i += (size_t)gridDim.x * blockDim.x) {
        float4 o = ((float4*)out)[i]; const float4 g = ((const float4*)gp)[i], q = ((const float4*)pp)[i];
        o.x += q.x / (1.0f + expf(-g.x)); o.y += q.y / (1.0f + expf(-g.y)); o.z += q.z / (1.0f + expf(-g.z)); o.w += q.w / (1.0f + expf(-g.w));
        ((float4*)out)[i] = o;
    }
}

struct Bufs { float *hn, *proj, *att, *h1, *qv, *gp, *pp; int* expert; float* gate; };
inline Bufs carve(void* d_ws) {
    char* w = (char*)d_ws; const size_t MiB = 1u << 20;
    Bufs b;
    b.hn = (float*)(w + 0);
    b.proj = (float*)(w + 64 * MiB);
    b.att = (float*)(w + 304 * MiB);
    b.h1 = (float*)(w + 368 * MiB);
    b.qv = (float*)(w + 64 * MiB);
    b.gp = (float*)(w + 128 * MiB);
    b.pp = (float*)(w + 192 * MiB);
    b.expert = (int*)(w + 256 * MiB);
    b.gate = (float*)(w + 260 * MiB);
    return b;
}

inline void run_stages(void* const* d_in, void* d_out, const Bufs& b, int from, int to, hipStream_t st) {
    const float* x = (const float*)d_in[0]; const float* p = (const float*)d_in[1]; const int* positions = (const int*)d_in[2];
    const float* norm_mix = (const float*)d_in[3]; const float* w_in = (const float*)d_in[4];
    const float* gqa = (const float*)d_in[5]; const float* gqb = (const float*)d_in[6]; const float* rel_bias = (const float*)d_in[7];
    const float* w_out = (const float*)d_in[8]; const float* norm_ffn = (const float*)d_in[9]; const float* peer_query = (const float*)d_in[10];
    const float* subk = (const float*)d_in[11]; const float* U = (const float*)d_in[12]; const float* V = (const float*)d_in[13];
    const float* norm_ple = (const float*)d_in[14]; const float* ple_gate = (const float*)d_in[15]; const float* ple_proj = (const float*)d_in[16];
    float* out = (float*)d_out;
#define ST(k) (from <= (k) && (k) < to)
    if (ST(0)) {
        k_rmsnorm<<<T, 256, 0, st>>>(x, norm_mix, b.hn);
        if (NAIVE_RB) { k_sgemm<false, true><<<dim3((NPROJ + 127) / 128, T / 128), 256, 0, st>>>(b.hn, w_in, b.proj, nullptr, T, NPROJ, D); k_postproj<true><<<T, 256, 0, st>>>(b.proj, positions, gqa, gqb); }
        else { k_sgemm<false><<<dim3((NPROJ + 127) / 128, T / 128), 256, 0, st>>>(b.hn, w_in, b.proj, nullptr, T, NPROJ, D); k_postproj<false><<<T, 256, 0, st>>>(b.proj, positions, gqa, gqb); }
    }
    if (ST(1)) {
        k_mixa<<<T * 8 / 4, 256, 0, st>>>(b.proj, rel_bias, b.att);
        k_dsa<<<T, 256, 0, st>>>(b.proj, b.att);
    }
    if (ST(2)) k_sgemm<true><<<dim3(D / 128, T / 128), 256, 0, st>>>(b.att, w_out, b.h1, x, T, D, D);
    if (ST(3)) {
        k_rmsnorm<<<T, 256, 0, st>>>(b.h1, norm_ffn, b.hn);
        k_sgemm<false><<<dim3(D / 128, T / 128), 256, 0, st>>>(b.hn, peer_query, b.qv, nullptr, T, D, D);
        k_peer_route<<<T * 8 / 4, 256, 0, st>>>(b.qv, subk, b.expert, b.gate);
        k_peer_experts<<<T, 256, 0, st>>>(b.hn, b.expert, b.gate, U, V, b.h1, out);
    }
    if (ST(4)) {
        k_rmsnorm<<<T, 256, 0, st>>>(out, norm_ple, b.hn);
        k_sgemm<false><<<dim3(D / 128, T / 128), 256, 0, st>>>(b.hn, ple_gate, b.gp, nullptr, T, D, D);
        k_sgemm<false><<<dim3(D / 128, T / 128), 256, 0, st>>>(p, ple_proj, b.pp, nullptr, T, D, PLE);
        k_ple_final<<<2048, 256, 0, st>>>(out, b.gp, b.pp, (size_t)T * D / 4);
    }
#undef ST
}
inline void run(void* const* d_in, void* d_out, void* d_ws, hipStream_t st) { run_stages(d_in, d_out, carve(d_ws), 0, 5, st); }
inline Bufs carve_hybrid(void* d_ws) {
    char* w = (char*)d_ws; const size_t MiB = 1u << 20;
    Bufs b;
    b.proj = (float*)(w + 0); b.att = (float*)(w + 228 * MiB); b.h1 = (float*)(w + 292 * MiB); b.hn = (float*)(w + 356 * MiB);
    b.qv = (float*)(w + 0); b.gp = (float*)(w + 64 * MiB); b.pp = (float*)(w + 128 * MiB); b.expert = (int*)(w + 192 * MiB); b.gate = (float*)(w + 196 * MiB);
    return b;
}
}
namespace pg8 {
#define PG8_LAS __attribute__((address_space(3)))
typedef unsigned short bf16_t;
typedef short bf16x8 __attribute__((ext_vector_type(8)));
typedef float f32x4 __attribute__((ext_vector_type(4)));
typedef unsigned u32x4 __attribute__((ext_vector_type(4)));
constexpr int BM = 256, BK = 64, HALF = 128, HTB = HALF * BK * 2  , STAGE_BYTES = 8 * HTB, NXCD = 8, WGM = 8;

__host__ __device__ __forceinline__ int lds_byte(int r, int c) { const int st = (r >> 4) * 2 + (c >> 5), rr = r & 15, cc = c & 31, ob = rr * 64 + cc * 2; return st * 1024 + (ob ^ (((ob >> 9) & 1) << 5)); }
__host__ __device__ __forceinline__ void stage_rc(int b, int& R, int& C) { const int st = b / 1024, sb = b % 1024, swz = sb ^ (((sb >> 9) & 1) << 5); R = (st >> 1) * 16 + swz / 64; C = (st & 1) * 32 + (swz % 64) / 2; }
__host__ __device__ __forceinline__ int perm32(int rho) { const int n = rho >> 4, i = rho & 15; return 8 * (i >> 2) + 4 * n + (i & 3); }

struct Unit { int pm, pn; };
struct Gemm { const bf16_t* A; const bf16_t* Bt; int M, N, K; };

struct StaticOrder {
    int nM, nN, nwg, G, c;
    __host__ __device__ void init(int M, int N, int G_, int c_) { nM = M / BM; nN = N / BM; nwg = nM * nN; G = G_; c = c_; }
    __host__ __device__ bool next(int i, Unit& u) const {
        const long L = (long)i * G + c; if (L >= nwg) return false;
        int wgid = (int)L; { const int q = nwg / NXCD, r = nwg % NXCD, xcd = wgid % NXCD, off = wgid / NXCD; wgid = (xcd < r ? xcd * (q + 1) : r * (q + 1) + (xcd - r) * q) + off; }
        const int nig = WGM * nN, gid = wgid / nig, fm = gid * WGM, gsz = (nM - fm) < WGM ? (nM - fm) : WGM;
        u.pm = fm + ((wgid % nig) % gsz); u.pn = (wgid % nig) / gsz; return true;
    }
    __device__ __forceinline__ void a_ready(const Unit&) const {}
    __device__ __forceinline__ void done(const Unit&) const {}
};
__device__ __forceinline__ unsigned cvt_pk_bf16(float lo, float hi) { unsigned r; asm volatile("v_cvt_pk_bf16_f32 %0, %1, %2" : "=v"(r) : "v"(lo), "v"(hi)); return r; }
typedef float f32x2 __attribute__((ext_vector_type(2)));
typedef int i32x4 __attribute__((ext_vector_type(4)));
template <bool I8> struct AccSel { typedef f32x4 type; };
template <> struct AccSel<true> { typedef i32x4 type; };
template <bool I8> __device__ __forceinline__ typename AccSel<I8>::type mma1(const bf16x8& b, const bf16x8& a, const typename AccSel<I8>::type& c) {
    if constexpr (I8) return __builtin_amdgcn_mfma_i32_16x16x64_i8(__builtin_bit_cast(i32x4, b), __builtin_bit_cast(i32x4, a), c, 0, 0, 0);
    else return __builtin_amdgcn_mfma_f32_16x16x32_bf16(b, a, c, 0, 0, 0);
}
template <class Epi, class Sched, bool ALIGN_EPI = false, bool SP2 = false, bool I8 = false>
__device__ __forceinline__ void gemm_phase(PG8_LAS unsigned char* lds, const Gemm g, const Sched& S, const Epi& E) {
    int tid_ = threadIdx.x; asm volatile("" : "+v"(tid_));
    const int tid = tid_, wid = __builtin_amdgcn_readfirstlane(tid >> 6), lane = tid & 63, wr = wid >> 2, wc = wid & 3, fr = lane & 15, fq = lane >> 4;
    const int K = g.K, nt = K / BK;
    unsigned voffA[2], voffB[2];
#pragma unroll
    for (int i = 0; i < 2; ++i) { int R, C; stage_rc(tid * 16 + i * 8192, R, C); const int Rb = Epi::PERM ? ((R & ~31) + perm32(R & 31)) : R;
        voffA[i] = (unsigned)(R * K + C) * 2u; voffB[i] = (unsigned)(Rb * K + C) * 2u; }
    const size_t kstep = (size_t)(BK * 2);
    const size_t hstep = (size_t)HALF * K * 2;
    const size_t tstep = 2 * hstep;
    const unsigned ldsw = (unsigned)wid * 1024u;
    const int aoff = lds_byte(wr * 64 + fr, fq * 8), boff = lds_byte(wc * 32 + fr, fq * 8);
#define PG8_SA(b, h) (((b) * 2 + (h)) * HTB)
#define PG8_SB(b, h) ((4 + (b) * 2 + (h)) * HTB)
#define PG8_STAGE(bufoff, gbase, voff) do { _Pragma("unroll") for (int _i = 0; _i < 2; ++_i) \
        __builtin_amdgcn_global_load_lds((const unsigned*)((const char*)(gbase) + (voff)[_i]), (PG8_LAS unsigned*)(lds + (bufoff) + ldsw + _i * 8192), 16, 0, 0); } while (0)
#define PG8_LDA(dst, b, h) do { _Pragma("unroll") for (int m = 0; m < 4; ++m) _Pragma("unroll") for (int k = 0; k < 2; ++k) dst[m][k] = *(const PG8_LAS bf16x8*)(lds + PG8_SA(b, h) + aoff + m * 2048 + k * 1024); } while (0)
#define PG8_LDB(dst, b, h) do { _Pragma("unroll") for (int n = 0; n < 2; ++n) _Pragma("unroll") for (int k = 0; k < 2; ++k) dst[n][k] = *(const PG8_LAS bf16x8*)(lds + PG8_SB(b, h) + boff + n * 2048 + k * 1024); } while (0)
#define PG8_MMA(ai, bj, At, Bt) do { __builtin_amdgcn_s_setprio(1); _Pragma("unroll") for (int m = 0; m < 4; ++m) _Pragma("unroll") for (int n = 0; n < 2; ++n) _Pragma("unroll") for (int k = 0; k < 2; ++k) \
        acc[ai][bj][m][n] = mma1<I8>(Bt[n][k], At[m][k], acc[ai][bj][m][n]); __builtin_amdgcn_s_setprio(0); } while (0)
#define PG8_WAIT_V(n) asm volatile("s_waitcnt vmcnt(" #n ")" ::: "memory")
#define PG8_WAIT_L(n) asm volatile("s_waitcnt lgkmcnt(" #n ")" ::: "memory")
#define PG8_BAR __builtin_amdgcn_s_barrier()
#define PG8_SCHED __builtin_amdgcn_sched_barrier(0)
    Unit cur, nxt; int ui = 0;
    if (!S.next(0, cur)) return;
    typedef typename AccSel<I8>::type acc_t;
    acc_t acc[2][2][4][2];
#pragma unroll
    for (int a = 0; a < 2; ++a)
#pragma unroll
        for (int b = 0; b < 2; ++b)
#pragma unroll
            for (int m = 0; m < 4; ++m)
#pragma unroll
                for (int n = 0; n < 2; ++n) acc[a][b][m][n] = acc_t{};
    bf16x8 At[4][2], B0[2][2], B1[2][2];
    const char* cA = (const char*)g.A + (size_t)cur.pm * tstep; const char* cB = (const char*)g.Bt + (size_t)cur.pn * tstep;
    S.a_ready(cur);
    if constexpr (SP2) {
        PG8_STAGE(PG8_SB(0, 0), cB, voffB); PG8_STAGE(PG8_SB(0, 1), cB + hstep, voffB); PG8_STAGE(PG8_SA(0, 0), cA, voffA); PG8_STAGE(PG8_SA(0, 1), cA + hstep, voffA);
        if (wr == 1) PG8_BAR;
        PG8_WAIT_V(2); PG8_BAR;
        PG8_STAGE(PG8_SB(1, 0), cB + kstep, voffB); PG8_STAGE(PG8_SA(1, 0), cA + kstep, voffA); PG8_STAGE(PG8_SB(1, 1), cB + hstep + kstep, voffB);
        PG8_WAIT_V(6); PG8_BAR;
    } else {
        PG8_STAGE(PG8_SB(0, 0), cB, voffB); PG8_STAGE(PG8_SA(0, 0), cA, voffA); PG8_STAGE(PG8_SB(0, 1), cB + hstep, voffB); PG8_STAGE(PG8_SA(0, 1), cA + hstep, voffA);
        if (wr == 1) PG8_BAR;
        PG8_WAIT_V(4); PG8_BAR;
        PG8_STAGE(PG8_SB(1, 0), cB + kstep, voffB); PG8_STAGE(PG8_SA(1, 0), cA + kstep, voffA); PG8_STAGE(PG8_SB(1, 1), cB + hstep + kstep, voffB);
        PG8_WAIT_V(6); PG8_BAR;
    }
    for (;;) {
        const bool has_next = S.next(ui + 1, nxt);
        const char* nA = has_next ? (const char*)g.A + (size_t)nxt.pm * tstep : cA; const char* nB = has_next ? (const char*)g.Bt + (size_t)nxt.pn * tstep : cB;
        for (int t = 0; t < nt; t += 2) {
            const bool last = (t == nt - 2);
            const char* a1 = cA + (size_t)(t + 1) * kstep;
            const char* a2 = last ? nA : cA + (size_t)(t + 2) * kstep; const char* b2 = last ? nB : cB + (size_t)(t + 2) * kstep;
            const char* a3 = a2 + kstep; const char* b3 = b2 + kstep;
            if (last && has_next) S.a_ready(nxt);
            if constexpr (SP2) {
            PG8_LDB(B0, 0, 0); PG8_LDB(B1, 0, 1); PG8_SCHED; PG8_LDA(At, 0, 0); PG8_STAGE(PG8_SA(1, 1), a1 + hstep, voffA);
            PG8_WAIT_V(8); PG8_WAIT_L(0); PG8_BAR; PG8_MMA(0, 0, At, B0); PG8_MMA(0, 1, At, B1); PG8_BAR; PG8_SCHED;
            PG8_LDA(At, 0, 1); PG8_STAGE(PG8_SB(0, 0), b2, voffB); PG8_STAGE(PG8_SB(0, 1), b2 + hstep, voffB); PG8_STAGE(PG8_SA(0, 0), a2, voffA);
            PG8_WAIT_V(8); PG8_WAIT_L(0); PG8_BAR; PG8_MMA(1, 0, At, B0); PG8_MMA(1, 1, At, B1); PG8_BAR; PG8_SCHED;
            PG8_LDB(B0, 1, 0); PG8_LDB(B1, 1, 1); PG8_SCHED; PG8_LDA(At, 1, 0); PG8_STAGE(PG8_SA(0, 1), a2 + hstep, voffA);
            PG8_WAIT_V(8); PG8_WAIT_L(0); PG8_BAR; PG8_MMA(0, 0, At, B0); PG8_MMA(0, 1, At, B1); PG8_BAR; PG8_SCHED;
            PG8_LDA(At, 1, 1); PG8_STAGE(PG8_SB(1, 0), b3, voffB); PG8_STAGE(PG8_SB(1, 1), b3 + hstep, voffB); PG8_STAGE(PG8_SA(1, 0), a3, voffA);
            PG8_WAIT_V(8); PG8_WAIT_L(0); PG8_BAR; PG8_MMA(1, 0, At, B0); PG8_MMA(1, 1, At, B1); PG8_BAR; PG8_SCHED;
            } else {
            PG8_LDB(B0, 0, 0); PG8_SCHED; PG8_LDA(At, 0, 0); PG8_STAGE(PG8_SA(1, 1), a1 + hstep, voffA);
            PG8_WAIT_L(8); PG8_BAR; PG8_WAIT_L(0); PG8_MMA(0, 0, At, B0); PG8_BAR; PG8_SCHED;
            PG8_LDB(B1, 0, 1); PG8_STAGE(PG8_SB(0, 0), b2, voffB);
            PG8_BAR; PG8_WAIT_L(0); PG8_MMA(0, 1, At, B1); PG8_BAR;
            PG8_LDA(At, 0, 1); PG8_STAGE(PG8_SA(0, 0), a2, voffA);
            PG8_BAR; PG8_WAIT_L(0); PG8_MMA(1, 0, At, B0); PG8_BAR; PG8_SCHED;
            PG8_STAGE(PG8_SB(0, 1), b2 + hstep, voffB);
            PG8_WAIT_V(6); PG8_BAR; PG8_MMA(1, 1, At, B1); PG8_BAR;
            PG8_LDB(B0, 1, 0); PG8_SCHED; PG8_LDA(At, 1, 0); PG8_STAGE(PG8_SA(0, 1), a2 + hstep, voffA);
            PG8_WAIT_L(8); PG8_BAR; PG8_WAIT_L(0); PG8_MMA(0, 0, At, B0); PG8_BAR; PG8_SCHED;
            PG8_LDB(B1, 1, 1); PG8_STAGE(PG8_SB(1, 0), b3, voffB);
            PG8_BAR; PG8_WAIT_L(0); PG8_MMA(0, 1, At, B1); PG8_BAR;
            PG8_LDA(At, 1, 1); PG8_STAGE(PG8_SA(1, 0), a3, voffA);
            PG8_BAR; PG8_WAIT_L(0); PG8_MMA(1, 0, At, B0); PG8_BAR; PG8_SCHED;
            PG8_STAGE(PG8_SB(1, 1), b3 + hstep, voffB);
            PG8_WAIT_V(6); PG8_BAR; PG8_MMA(1, 1, At, B1); PG8_BAR;
            }
        }
        if constexpr (ALIGN_EPI) { if (wr == 0) PG8_BAR; }
        if constexpr (!Epi::AFTER_DRAIN) { E(acc, cur, wr, wc, fr, fq); S.done(cur); }
        if (!has_next) break;
#pragma unroll
        for (int a = 0; a < 2; ++a)
#pragma unroll
            for (int b = 0; b < 2; ++b)
#pragma unroll
                for (int m = 0; m < 4; ++m)
#pragma unroll
                    for (int n = 0; n < 2; ++n) acc[a][b][m][n] = acc_t{};
        cur = nxt; cA = nA; cB = nB; ++ui;
        if constexpr (ALIGN_EPI) { if (wr == 1) PG8_BAR; }
    }
    PG8_WAIT_V(0);
    if constexpr (!ALIGN_EPI) { if (wr == 0) PG8_BAR; }
    PG8_BAR;
    if constexpr (Epi::AFTER_DRAIN) { E.fused(acc, cur, wr, wc, fr, fq, lds, wid, lane); S.done(cur); }
#undef PG8_SA
#undef PG8_SB
#undef PG8_STAGE
#undef PG8_LDA
#undef PG8_LDB
#undef PG8_MMA
#undef PG8_WAIT_V
#undef PG8_WAIT_L
#undef PG8_BAR
#undef PG8_SCHED
}
}
#include <hip/hip_cooperative_groups.h>
namespace fk {
using namespace cfg;
namespace cg = cooperative_groups;
#define LAS __attribute__((address_space(3)))
typedef unsigned short bf16_t;
typedef short bf16x8 __attribute__((ext_vector_type(8)));
typedef short s16x4 __attribute__((ext_vector_type(4)));
typedef float f32x4 __attribute__((ext_vector_type(4)));
typedef float f32x2 __attribute__((ext_vector_type(2)));
typedef float f32x16 __attribute__((ext_vector_type(16)));
typedef unsigned u32x4 __attribute__((ext_vector_type(4)));
typedef unsigned u32x2 __attribute__((ext_vector_type(2)));

constexpr int NWAVES = 8, NTHR = 512;
constexpr int LDS_BYTES = 160 * 1024;
constexpr int RING_BYTES = 131072;
constexpr int EPI_OFF = RING_BYTES;
constexpr int NPAD = 7424;

constexpr size_t MiB = 1u << 20;
constexpr size_t WS_CTL_BYTES = 128 * 1024;
constexpr size_t WS_BAR = 0;
constexpr size_t WS_WIN = 1 * MiB;
constexpr size_t WS_WOUT = 30 * MiB;
constexpr size_t WS_WPQ = 38 * MiB;
constexpr size_t WS_WG = 46 * MiB;
constexpr size_t WS_WP = 54 * MiB;
constexpr size_t WS_SUBK = 55 * MiB;
constexpr size_t WS_ROPE = 56 * MiB;
constexpr size_t WS_RS1 = 58 * MiB;
constexpr size_t WS_SCL = 59 * MiB;
constexpr size_t WS_RS3 = 60 * MiB;
constexpr size_t WS_UB = 64 * MiB;
constexpr size_t WS_VB = 128 * MiB;
constexpr size_t WS_XB = 192 * MiB;
constexpr size_t WS_QA = 224 * MiB, WS_KA = 240 * MiB, WS_VA = 256 * MiB, WS_QB = 272 * MiB, WS_KB = 288 * MiB, WS_VBB = 304 * MiB;
constexpr size_t WS_QI = 320 * MiB;
constexpr size_t WS_KI = 336 * MiB;
constexpr size_t WS_WI = 337 * MiB;
constexpr size_t WS_BM = 338 * MiB;
constexpr size_t WS_SC = 342 * MiB;
constexpr size_t WS_O = 470 * MiB;
constexpr size_t WS_H1 = 342 * MiB;
constexpr size_t WS_H1B = 406 * MiB;
constexpr size_t WS_X8 = 438 * MiB;
constexpr size_t WS_GATE = 454 * MiB;
constexpr size_t WS_EXP = 458 * MiB;
constexpr size_t WS_CP = 462 * MiB;
constexpr size_t WS_SX = 466 * MiB;
constexpr size_t WS_SSQP = 467 * MiB;
constexpr size_t WS_QCNT = 64 * 1024;
constexpr size_t WS_PB = 502 * MiB;
constexpr size_t WS_PP = 224 * MiB;
constexpr size_t WS_X8IN = 342 * MiB;
constexpr size_t WS_W8IN = 358 * MiB;
constexpr size_t WS_SWIN = 374 * MiB;
constexpr size_t WS_WG8 = 376 * MiB;
constexpr size_t WS_SWG = 380 * MiB;
constexpr size_t WS_H2Q = 382 * MiB;
constexpr size_t WS_SAH2 = 398 * MiB;
constexpr size_t WS_WPQ8 = 399 * MiB;
constexpr size_t WS_SWPQ = 403 * MiB;
constexpr size_t WS_AMAX1 = 398 * MiB + 65536;
constexpr size_t WS_END = 506 * MiB;

__device__ __forceinline__ unsigned f2bf(float f) { unsigned u = __builtin_bit_cast(unsigned, f); return (u + 0x7fffu + ((u >> 16) & 1u)) >> 16; }
__device__ __forceinline__ unsigned pk2(float lo, float hi) { return f2bf(lo) | (f2bf(hi) << 16); }
__device__ __forceinline__ float bf2f(unsigned short b) { return __builtin_bit_cast(float, (unsigned)b << 16); }
__device__ __forceinline__ float wave_sum(float v) {
#pragma unroll
    for (int o = 1; o < 64; o <<= 1) v += __shfl_xor(v, o);
    return v;
}
#define LDS_WAIT() asm volatile("s_waitcnt lgkmcnt(0)" ::: "memory")

struct Args {
    const float* in[17];
    float* out;
    unsigned char* ws;
    int ph_lo, ph_hi, rep_phase, pad;
};

struct Ctx {
    int tid, lane, wave, G, vcu, bid;
    LAS unsigned char* lds;
};
#define XB_TMO      128
#define XB_XCNT(j)  (256  + 64 * (j))
#define XB_XSUB(j)  (1280 + 64 * (j))
#define XB_XGEN(j)  (2304 + 64 * (j))
#define XB_TOP      3328
#define XB_TOPGEN   3392
#define XCD_BAR_WORDS 3456
#define XB_SPIN_CAP (1u << 18)

__device__ __forceinline__ unsigned xb_ld(unsigned* p)              { return __hip_atomic_load(p, __ATOMIC_RELAXED, __HIP_MEMORY_SCOPE_AGENT); }
__device__ __forceinline__ unsigned xb_add(unsigned* p, unsigned v) { return __hip_atomic_fetch_add(p, v, __ATOMIC_RELAXED, __HIP_MEMORY_SCOPE_AGENT); }
__device__ __forceinline__ unsigned xb_xcc_id() { return (unsigned)__builtin_amdgcn_s_getreg((3 << 11) | 20) & 0xFu; }
#define XB_SPIN(cond, bar) do { unsigned _sp = 0; while (cond) { __builtin_amdgcn_s_sleep(1); \
    if ((++_sp & 255u) == 0u) { if (xb_ld(&(bar)[XB_TMO])) break; if (_sp > XB_SPIN_CAP) { atomicAdd(&(bar)[XB_TMO], 1u); break; } } } } while (0)

struct XcdBarrier {
    unsigned* bar; unsigned x;
    volatile LAS unsigned* st;
};

__device__ __forceinline__ XcdBarrier xcd_barrier_post(unsigned* bar, volatile LAS unsigned* st) {
    XcdBarrier b; b.bar = bar; b.x = xb_xcc_id(); b.st = st;
    if (threadIdx.x == 0) (void)xb_add(&bar[XB_XCNT(b.x)], 1u);
    return b;
}
__device__ __forceinline__ void xcd_barrier_complete(unsigned* bar, unsigned x, unsigned& nloc, unsigned& nx) {
    const unsigned G = gridDim.x * gridDim.y * gridDim.z;
    unsigned sum, cnt, mine, sp = 0u;
    for (;;) {
        sum = 0u; cnt = 0u; mine = 0u;
#pragma unroll
        for (unsigned j = 0; j < 16; ++j) { const unsigned c = xb_ld(&bar[XB_XCNT(j)]); sum += c; cnt += (c > 0u) ? 1u : 0u; mine = (j == x) ? c : mine; }
        if (sum == G) break;
        __builtin_amdgcn_s_sleep(1);
        if ((++sp & 255u) == 0u) { if (xb_ld(&bar[XB_TMO])) break; if (sp > XB_SPIN_CAP) { atomicAdd(&bar[XB_TMO], 1u); break; } }
    }
    nloc = mine > 0u ? mine : 1u; nx = cnt > 0u ? cnt : 1u;
}

__device__ __forceinline__ void xcd_barrier(const XcdBarrier& b) {
    asm volatile("s_waitcnt vmcnt(0)" ::: "memory");
    __syncthreads();
    if (threadIdx.x == 0) {
        unsigned* bar = b.bar;
        __builtin_amdgcn_s_waitcnt(0);
        unsigned nloc = b.st[0], nx = b.st[1];
        if (nloc == 0u) { xcd_barrier_complete(bar, b.x, nloc, nx); b.st[0] = nloc; b.st[1] = nx; }
        const unsigned old = xb_add(&bar[XB_XSUB(b.x)], 1u);
        const unsigned gen = old / nloc;
        if (old + 1u == (gen + 1u) * nloc) {
            __builtin_amdgcn_fence(__ATOMIC_RELEASE, "agent");
            asm volatile("s_waitcnt vmcnt(0)" ::: "memory");
            const unsigned og = xb_add(&bar[XB_TOP], 1u);
            const unsigned tg = og / nx;
            if (og + 1u == (tg + 1u) * nx) xb_add(&bar[XB_TOPGEN], 1u);
            else XB_SPIN(xb_ld(&bar[XB_TOPGEN]) == tg, bar);
            __builtin_amdgcn_fence(__ATOMIC_ACQUIRE, "agent");
            xb_add(&bar[XB_XGEN(b.x)], 1u);
            asm volatile("s_waitcnt vmcnt(0)" ::: "memory");
        } else {
            XB_SPIN(xb_ld(&bar[XB_XGEN(b.x)]) == gen, bar);
            __builtin_amdgcn_fence(__ATOMIC_ACQUIRE, "agent");
            asm volatile("s_waitcnt vmcnt(0)" ::: "memory");
        }
    }
    __syncthreads();
}

__device__ __forceinline__ void p0_transpose_item(const float* __restrict__ W, const float* __restrict__ g, int K, int N, bf16_t* __restrict__ WT, LAS float* scr, int item, int nblk, int lane) {
    const int kb = item / nblk, nb = item % nblk, k0 = 64 * kb, n0 = 32 * nb;
    const int n = n0 + 4 * (lane & 7);
#pragma unroll
    for (int i = 0; i < 8; ++i) {
        const int kk = 8 * i + (lane >> 3);
        f32x4 v = (n < N) ? *(const f32x4*)(W + (size_t)(k0 + kk) * N + n) : (f32x4){0.f, 0.f, 0.f, 0.f};
        if (g) v = v * g[k0 + kk];
        LAS float* d = scr + kk * 33 + 4 * (lane & 7);
        d[0] = v.x; d[1] = v.y; d[2] = v.z; d[3] = v.w;
    }
    LDS_WAIT(); asm volatile("" ::: "memory");
    const int c = lane & 7;
#pragma unroll
    for (int j = 0; j < 4; ++j) {
        const int nn = (lane >> 3) + 8 * j; const LAS float* s = scr + (8 * c) * 33 + nn;
        u32x4 o; o.x = pk2(s[0 * 33], s[1 * 33]); o.y = pk2(s[2 * 33], s[3 * 33]); o.z = pk2(s[4 * 33], s[5 * 33]); o.w = pk2(s[6 * 33], s[7 * 33]);
        *(u32x4*)(WT + (size_t)(n0 + nn) * K + k0 + 8 * c) = o;
    }
    LDS_WAIT(); asm volatile("" ::: "memory");
}

__device__ __forceinline__ void p0_quant_row(const bf16_t* __restrict__ src, unsigned char* __restrict__ dst, float* __restrict__ scl, int lane) {
    const u32x4* r = (const u32x4*)src + 2 * lane;
    u32x4 w[4]; float mx = 0.f;
#pragma unroll
    for (int j = 0; j < 2; ++j) { w[2 * j] = r[128 * j]; w[2 * j + 1] = r[128 * j + 1]; }
    float f[32];
#pragma unroll
    for (int j = 0; j < 4; ++j) { const unsigned u[4] = {w[j].x, w[j].y, w[j].z, w[j].w};
#pragma unroll
        for (int q = 0; q < 4; ++q) { f[8 * j + 2 * q] = __uint_as_float(u[q] << 16); f[8 * j + 2 * q + 1] = __uint_as_float(u[q] & 0xffff0000u); } }
#pragma unroll
    for (int i = 0; i < 32; ++i) mx = fmaxf(mx, fabsf(f[i]));
#pragma unroll
    for (int o = 1; o < 64; o <<= 1) mx = fmaxf(mx, __shfl_xor(mx, o));
    const float inv = mx > 0.f ? 127.0f / mx : 0.f;
    if (lane == 0) *scl = mx * (1.0f / 127.0f);
#pragma unroll
    for (int j = 0; j < 2; ++j) {
        u32x4 o;
#define Q4(b_) (((unsigned)(int)rintf(f[16 * j + (b_)] * inv) & 0xffu) | (((unsigned)(int)rintf(f[16 * j + (b_) + 1] * inv) & 0xffu) << 8) | (((unsigned)(int)rintf(f[16 * j + (b_) + 2] * inv) & 0xffu) << 16) | (((unsigned)(int)rintf(f[16 * j + (b_) + 3] * inv) & 0xffu) << 24))
        o.x = Q4(0); o.y = Q4(4); o.z = Q4(8); o.w = Q4(12);
#undef Q4
        *(u32x4*)(dst + 1024 * j + 16 * lane) = o;
    }
}

__device__ __forceinline__ void p0_wblock_lds(const Ctx& C, const float* __restrict__ W, const float* __restrict__ g, int N, int nb, unsigned char* __restrict__ W8, float* __restrict__ SW) {
    constexpr int PITCH = 4104;
    LAS unsigned char* img = C.lds;
    const int lane = C.lane, nl = 4 * (lane & 7), n = 32 * nb + nl, kq = lane >> 3;
#pragma unroll 1
    for (int i4 = 0; i4 < 4; ++i4) {
        const int k0 = 64 * (4 * C.wave + i4);
        f32x4 v[8];
#pragma unroll
        for (int i = 0; i < 8; ++i) {
            const int kk = k0 + 8 * i + kq;
            v[i] = (n < N) ? *(const f32x4*)(W + (size_t)kk * N + n) : (f32x4){0.f, 0.f, 0.f, 0.f};
            if (g) v[i] = v[i] * g[kk];
        }
#pragma unroll
        for (int i = 0; i < 8; ++i) {
            LAS unsigned short* d = (LAS unsigned short*)(img + nl * PITCH + 2 * (k0 + 8 * i + kq));
            d[0] = (unsigned short)f2bf(v[i].x); d[PITCH / 2] = (unsigned short)f2bf(v[i].y); d[2 * (PITCH / 2)] = (unsigned short)f2bf(v[i].z); d[3 * (PITCH / 2)] = (unsigned short)f2bf(v[i].w);
        }
    }
    __syncthreads();
#pragma unroll 1
    for (int r = 0; r < 4; ++r) {
        const int row = 4 * C.wave + r;
        float f[32]; float mx = 0.f;
#pragma unroll
        for (int j = 0; j < 2; ++j)
#pragma unroll
            for (int q = 0; q < 4; ++q) {
                const u32x2 w = *(const LAS u32x2*)(img + row * PITCH + 2 * (1024 * j + 16 * lane) + 8 * q);
                f[16 * j + 4 * q] = __uint_as_float(w.x << 16); f[16 * j + 4 * q + 1] = __uint_as_float(w.x & 0xffff0000u);
                f[16 * j + 4 * q + 2] = __uint_as_float(w.y << 16); f[16 * j + 4 * q + 3] = __uint_as_float(w.y & 0xffff0000u);
            }
#pragma unroll
        for (int i = 0; i < 32; ++i) mx = fmaxf(mx, fabsf(f[i]));
#pragma unroll
        for (int o = 1; o < 64; o <<= 1) mx = fmaxf(mx, __shfl_xor(mx, o));
        const float inv = mx > 0.f ? 127.0f / mx : 0.f;
        const int nrow = 32 * nb + row;
        if (lane == 0) SW[nrow] = mx * (1.0f / 127.0f);
#pragma unroll
        for (int j = 0; j < 2; ++j) {
            u32x4 o;
#define Q4(b_) (((unsigned)(int)rintf(f[16 * j + (b_)] * inv) & 0xffu) | (((unsigned)(int)rintf(f[16 * j + (b_) + 1] * inv) & 0xffu) << 8) | (((unsigned)(int)rintf(f[16 * j + (b_) + 2] * inv) & 0xffu) << 16) | (((unsigned)(int)rintf(f[16 * j + (b_) + 3] * inv) & 0xffu) << 24))
            o.x = Q4(0); o.y = Q4(4); o.z = Q4(8); o.w = Q4(12);
#undef Q4
            *(u32x4*)(W8 + (size_t)nrow * D + 1024 * j + 16 * lane) = o;
        }
    }
    __syncthreads();
}

__device__ __forceinline__ void p0_prologue(const Ctx& C, const Args& a) {
    unsigned char* ws = a.ws;
    const int gw = C.vcu * NWAVES + C.wave, NGW = C.G * NWAVES;
    const int gt = C.vcu * NTHR + C.tid, NGT = C.G * NTHR;
    for (int nb = C.vcu; nb < NPAD / 32; nb += C.G) p0_wblock_lds(C, a.in[4], a.in[3], NPROJ, nb, ws + WS_W8IN, (float*)(ws + WS_SWIN));
    {
        const float* x = a.in[0]; bf16_t* xb = (bf16_t*)(ws + WS_XB); float* rs1 = (float*)(ws + WS_RS1);
        for (int m = gw; m < T; m += NGW) {
            const f32x4* xr = (const f32x4*)(x + (size_t)m * D) + C.lane;
            f32x4 v[8]; float s = 0.f;
#pragma unroll
            for (int j = 0; j < 8; ++j) { v[j] = xr[64 * j]; s += (v[j].x * v[j].x + v[j].y * v[j].y) + (v[j].z * v[j].z + v[j].w * v[j].w); }
            s = wave_sum(s);
            float mx = 0.f;
#pragma unroll
            for (int j = 0; j < 8; ++j) mx = fmaxf(fmaxf(mx, fmaxf(fabsf(v[j].x), fabsf(v[j].y))), fmaxf(fabsf(v[j].z), fabsf(v[j].w)));
#pragma unroll
            for (int o = 1; o < 64; o <<= 1) mx = fmaxf(mx, __shfl_xor(mx, o));
            const float inv = mx > 0.f ? 127.0f / mx : 0.f;
            if (C.lane == 0) rs1[m] = rsqrtf(s * (1.0f / D) + EPS) * (mx * (1.0f / 127.0f));
            {
                unsigned* q8 = (unsigned*)(ws + WS_X8IN + (size_t)m * D) + C.lane;
#pragma unroll
                for (int j = 0; j < 8; ++j)
                    q8[64 * j] = ((unsigned)(int)rintf(v[j].x * inv) & 0xffu) | (((unsigned)(int)rintf(v[j].y * inv) & 0xffu) << 8) | (((unsigned)(int)rintf(v[j].z * inv) & 0xffu) << 16) | (((unsigned)(int)rintf(v[j].w * inv) & 0xffu) << 24);
            }
            u32x2* o8 = (u32x2*)(xb + (size_t)m * D) + C.lane;
#pragma unroll
            for (int j = 0; j < 8; ++j) { u32x2 w; w.x = pk2(v[j].x, v[j].y); w.y = pk2(v[j].z, v[j].w); o8[64 * j] = w; }
        }
    }
    {
        const int* pos = (const int*)a.in[2]; f32x2* rope = (f32x2*)(ws + WS_ROPE);
        for (int i = gt; i < T * 24; i += NGT) {
            const int t = i / 24, k = i % 24;
            const double fr = (k < 16) ? (double)k / 16.0 : (double)(k - 16) / 8.0;
            const double ang = (double)pos[t] * exp(-13.122363377404328 * fr);
            f32x2 cs; cs.x = (float)cos(ang); cs.y = (float)sin(ang);
            rope[i] = cs;
        }
    }
}

constexpr int DT_TR = (((D / 64) * (D / 32) + (PLE / 64) * (D / 32)) + 7) / 8;
constexpr int DT_WG = 2 * (D / 32);
constexpr int DT_UV = 2 * PK * PK / 32;
constexpr int DT_P = 64;
constexpr int DT_N = DT_TR + DT_WG + DT_UV + DT_P + 1;
__device__ __forceinline__ void p0_task(const Ctx& C, const Args& a, int task) {
    unsigned char* ws = a.ws;
    if (task < DT_TR) {
        constexpr int I_SQ = (D / 64) * (D / 32), I_PP = (PLE / 64) * (D / 32);
        LAS float* scr = (LAS float*)(C.lds + C.wave * 16384);
        int r = task * 8 + C.wave;
        if (r < I_SQ) { p0_transpose_item(a.in[8], nullptr, D, D, (bf16_t*)(ws + WS_WOUT), scr, r, D / 32, C.lane); return; } r -= I_SQ;
        if (r < I_PP) p0_transpose_item(a.in[16], nullptr, PLE, D, (bf16_t*)(ws + WS_WP), scr, r, D / 32, C.lane);
        return;
    }
    task -= DT_TR;
    if (task < DT_WG) {
        const bool isg = task >= D / 32; const int nb = isg ? task - D / 32 : task;
        p0_wblock_lds(C, isg ? a.in[15] : a.in[10], isg ? a.in[14] : nullptr, D, nb, ws + (isg ? WS_WG8 : WS_WPQ8), (float*)(ws + (isg ? WS_SWG : WS_SWPQ)));
        return;
    }
    task -= DT_WG;
    if (task < DT_UV) {
#pragma unroll 1
        for (int jr = 0; jr < 4; ++jr) {
            const int rowg = task * 32 + C.wave * 4 + jr, tsel = rowg >= PK * PK ? 1 : 0, row = rowg - tsel * PK * PK;
            const float* src = tsel ? a.in[13] : a.in[12]; unsigned char* dst = ws + (tsel ? WS_VB : WS_UB); float* scl = (float*)(ws + WS_SCL) + tsel * (PK * PK);
            const float* r = src + (size_t)row * D + C.lane * 16;
            f32x4 v[8]; float m = 0.f;
#pragma unroll
            for (int j = 0; j < 2; ++j)
#pragma unroll
                for (int q = 0; q < 4; ++q) { const f32x4 t4 = *(const f32x4*)(r + 1024 * j + 4 * q); v[4 * j + q] = t4;
                    m = fmaxf(fmaxf(m, fmaxf(fabsf(t4.x), fabsf(t4.y))), fmaxf(fabsf(t4.z), fabsf(t4.w))); }
#pragma unroll
            for (int o = 1; o < 64; o <<= 1) m = fmaxf(m, __shfl_xor(m, o));
            const float inv = m > 0.f ? 127.0f / m : 0.f;
            if (C.lane == 0) scl[row] = m * (1.0f / 127.0f);
#pragma unroll
            for (int j = 0; j < 2; ++j) {
                u32x4 w;
#define Q8(t4) (((unsigned)(int)rintf((t4).x * inv) & 0xffu) | (((unsigned)(int)rintf((t4).y * inv) & 0xffu) << 8) | (((unsigned)(int)rintf((t4).z * inv) & 0xffu) << 16) | (((unsigned)(int)rintf((t4).w * inv) & 0xffu) << 24))
                w.x = Q8(v[4 * j + 0]); w.y = Q8(v[4 * j + 1]); w.z = Q8(v[4 * j + 2]); w.w = Q8(v[4 * j + 3]);
#undef Q8
                if (tsel) *(u32x4*)(dst + (size_t)(4 * j + (C.lane >> 4)) * ((size_t)PK * PK * 256) + (size_t)row * 256 + (C.lane & 15) * 16) = w;
                else *(u32x4*)(dst + (size_t)row * D + C.lane * 16 + 1024 * j) = w;
            }
        }
        return;
    }
    task -= DT_UV;
    const bool is_p = task < DT_P;
    const f32x4* src = (const f32x4*)(is_p ? a.in[1] : a.in[11]); u32x4* dst = (u32x4*)(ws + (is_p ? WS_PB : WS_SUBK));
    const size_t base = is_p ? (size_t)task * 4096 : 0;
#pragma unroll 2
    for (int i = C.tid; i < 4096; i += NTHR) {
        const f32x4 a0 = src[2 * (base + i)], a1 = src[2 * (base + i) + 1];
        u32x4 w; w.x = pk2(a0.x, a0.y); w.y = pk2(a0.z, a0.w); w.z = pk2(a1.x, a1.y); w.w = pk2(a1.z, a1.w);
        dst[base + i] = w;
    }
}
__device__ __forceinline__ void st_wt(void* p, u32x2 v) {
    __hip_atomic_store((unsigned long long*)p, (unsigned long long)v.x | ((unsigned long long)v.y << 32), __ATOMIC_RELAXED, __HIP_MEMORY_SCOPE_AGENT);
}
constexpr int P1_IDX_TILES = 5 * (T / 256);
struct InProjOrder {
    pg8::StaticOrder so; unsigned* done_cnt;
    __device__ __forceinline__ bool next(int i, pg8::Unit& u) const {
        if (!so.next(i, u)) return false;
        const int p = u.pn; u.pn = (p < 3) ? 24 + p : (p < 15) ? p - 3 : (p < 17) ? 12 + p : p - 5; return true;
    }
    __device__ __forceinline__ void a_ready(const pg8::Unit&) const {}
    __device__ __forceinline__ void done(const pg8::Unit& u) const {
        if (u.pn >= 24) {
            asm volatile("s_waitcnt vmcnt(0)" ::: "memory");
            __builtin_amdgcn_s_barrier();
            if (threadIdx.x == 0) __hip_atomic_fetch_add(done_cnt, 1u, __ATOMIC_RELAXED, __HIP_MEMORY_SCOPE_AGENT);
        }
    }
};
struct EpiInProj {
    static constexpr bool PERM = false, AFTER_DRAIN = false;
    const float* rs1; const float* sw; const f32x2* rope; const float* gqa; const float* gqb;
    bf16_t *QKV0, *QI, *KI; float* WI;
    LAS float* scr;
    __device__ __forceinline__ void operator()(const pg8::i32x4 (&acci)[2][2][4][2], const pg8::Unit& u, int wr, int wc, int fr, int fq) const {
        const int pn = u.pn;
        f32x4 swv[2][2];
#pragma unroll
        for (int bj = 0; bj < 2; ++bj)
#pragma unroll
            for (int n = 0; n < 2; ++n) swv[bj][n] = *(const f32x4*)(sw + pn * 256 + bj * 128 + 32 * wc + 16 * n + 4 * fq);
#define ACCF(ai, bj, m, n) (__builtin_convertvector(acci[ai][bj][m][n], f32x4) * swv[bj][n])
        const int row0 = u.pm * 256 + wr * 64 + fr, rl0 = wr * 64 + fr;
        if (pn < 24) {
            const int grp = pn >> 2;
            const bool norm = (grp != 2 && grp != 5), rope_on = (grp == 3 || grp == 4);
            bf16_t* dst = QKV0 + (size_t)grp * (size_t)(8u << 20);
            const int colbase = (pn & 3) * 256 + 32 * wc + 4 * fq;
            f32x4 gv[2] = {(f32x4){1.f, 1.f, 1.f, 1.f}, (f32x4){1.f, 1.f, 1.f, 1.f}};
            if (norm) {
#pragma unroll
                for (int ai = 0; ai < 2; ++ai)
#pragma unroll
                    for (int m = 0; m < 4; ++m)
#pragma unroll
                        for (int bj = 0; bj < 2; ++bj) {
                            const f32x4 a0 = ACCF(ai, bj, m, 0), a1 = ACCF(ai, bj, m, 1);
                            float s = (a0.x * a0.x + a0.y * a0.y) + (a0.z * a0.z + a0.w * a0.w) + (a1.x * a1.x + a1.y * a1.y) + (a1.z * a1.z + a1.w * a1.w);
                            s += __shfl_xor(s, 16); s += __shfl_xor(s, 32);
                            if (fq == 0) scr[((ai * 128 + rl0 + m * 16) * 2 + bj) * 4 + wc] = s;
                        }
                const float* g = ((grp < 2) ? gqa : gqb) + ((grp == 1 || grp == 4) ? 128 : 0);
                gv[0] = *(const f32x4*)(g + 32 * wc + 4 * fq); gv[1] = *(const f32x4*)(g + 32 * wc + 16 + 4 * fq);
                asm volatile("s_waitcnt lgkmcnt(0)" ::: "memory"); __builtin_amdgcn_s_barrier(); asm volatile("" ::: "memory");
            }
#pragma unroll
            for (int ai = 0; ai < 2; ++ai)
#pragma unroll
                for (int m = 0; m < 4; ++m) {
                    const int row = row0 + ai * 128 + m * 16;
                    const float r = rs1[row];
                    f32x4 cs0 = (f32x4){1.f, 0.f, 1.f, 0.f}, cs1 = cs0;
                    if (rope_on && wc == 0) { const f32x4* rp = (const f32x4*)(rope + (size_t)row * 24 + 4 * fq); cs0 = rp[0]; cs1 = rp[1]; }
#pragma unroll
                    for (int bj = 0; bj < 2; ++bj) {
                        float sc = r;
                        if (norm) {
                            const f32x4 p4 = *(const LAS f32x4*)&scr[((ai * 128 + rl0 + m * 16) * 2 + bj) * 4];
                            const float tot = (p4.x + p4.y) + (p4.z + p4.w);
                            sc = r * rsqrtf(r * r * tot * (1.0f / 128.f) + EPS);
                        }
                        f32x4 y0 = ACCF(ai, bj, m, 0) * sc * gv[0], y1 = ACCF(ai, bj, m, 1) * sc * gv[1];
                        if (rope_on && wc == 0) {
                            const f32x4 x1 = y0, x2 = y1;
                            y0.x = x1.x * cs0.x - x2.x * cs0.y; y1.x = x2.x * cs0.x + x1.x * cs0.y;
                            y0.y = x1.y * cs0.z - x2.y * cs0.w; y1.y = x2.y * cs0.z + x1.y * cs0.w;
                            y0.z = x1.z * cs1.x - x2.z * cs1.y; y1.z = x2.z * cs1.x + x1.z * cs1.y;
                            y0.w = x1.w * cs1.z - x2.w * cs1.w; y1.w = x2.w * cs1.z + x1.w * cs1.w;
                        }
                        bf16_t* dp = dst + (size_t)row * 1024 + colbase + bj * 128;
                        u32x2 w0, w1; w0.x = pk2(y0.x, y0.y); w0.y = pk2(y0.z, y0.w); w1.x = pk2(y1.x, y1.y); w1.y = pk2(y1.z, y1.w);
                        *(u32x2*)dp = w0; *(u32x2*)(dp + 16) = w1;
                    }
                }
        } else {
            const bool is_qi = pn < 28;
#pragma unroll
            for (int ai = 0; ai < 2; ++ai)
#pragma unroll
                for (int m = 0; m < 4; ++m) {
                    const int row = row0 + ai * 128 + m * 16;
                    const float r = rs1[row];
                    f32x4 cs0 = (f32x4){1.f, 0.f, 1.f, 0.f}, cs1 = cs0;
                    if ((wc & 1) == 0) { const f32x4* rp = (const f32x4*)(rope + (size_t)row * 24 + 16 + 4 * (fq & 1)); cs0 = rp[0]; cs1 = rp[1]; }
#pragma unroll
                    for (int bj = 0; bj < 2; ++bj) {
                        if (!is_qi && bj == 1) continue;
                        f32x4 y0 = ACCF(ai, bj, m, 0) * r, y1 = ACCF(ai, bj, m, 1) * r;
                        if ((wc & 1) == 0 && (is_qi || wc == 0)) {
                            f32x4 pt; pt.x = __shfl_xor(y0.x, 32); pt.y = __shfl_xor(y0.y, 32); pt.z = __shfl_xor(y0.z, 32); pt.w = __shfl_xor(y0.w, 32);
                            const float sg = (fq < 2) ? -1.f : 1.f;
                            y0.x = y0.x * cs0.x + sg * pt.x * cs0.y; y0.y = y0.y * cs0.z + sg * pt.y * cs0.w;
                            y0.z = y0.z * cs1.x + sg * pt.z * cs1.y; y0.w = y0.w * cs1.z + sg * pt.w * cs1.w;
                        }
                        if (is_qi) {
                            bf16_t* dp = QI + (size_t)row * 1024 + (pn - 24) * 256 + bj * 128 + 32 * wc + 4 * fq;
                            u32x2 w0, w1; w0.x = pk2(y0.x, y0.y); w0.y = pk2(y0.z, y0.w); w1.x = pk2(y1.x, y1.y); w1.y = pk2(y1.z, y1.w);
                            st_wt(dp, w0); st_wt(dp + 16, w1);
                        } else if (wc < 2) {
                            bf16_t* dp = KI + (size_t)row * 64 + 32 * wc + 4 * fq;
                            u32x2 w0, w1; w0.x = pk2(y0.x, y0.y); w0.y = pk2(y0.z, y0.w); w1.x = pk2(y1.x, y1.y); w1.y = pk2(y1.z, y1.w);
                            st_wt(dp, w0); st_wt(dp + 16, w1);
                        } else if (wc == 2) {
                            const f32x4 wv = y0 * 0.03125f; float* wp_ = WI + (size_t)row * 16 + 4 * fq;
                            u32x2 w0, w1; w0.x = __float_as_uint(wv.x); w0.y = __float_as_uint(wv.y); w1.x = __float_as_uint(wv.z); w1.y = __float_as_uint(wv.w);
                            st_wt(wp_, w0); st_wt(wp_ + 2, w1);
                        }
                    }
                }
        }
    }
#undef ACCF
};

__device__ __forceinline__ void p1_inproj(const Ctx& C, const Args& a) {
    unsigned char* ws = a.ws;
    pg8::Gemm g{(const bf16_t*)(ws + WS_X8IN), (const bf16_t*)(ws + WS_W8IN), T, NPAD, D / 2};
    InProjOrder S; S.so.init(T, NPAD, C.G, C.bid); S.done_cnt = (unsigned*)(ws + WS_QCNT) + 64 * 18;
    EpiInProj E{(const float*)(ws + WS_RS1), (const float*)(ws + WS_SWIN), (const f32x2*)(ws + WS_ROPE), a.in[5], a.in[6],
                (bf16_t*)(ws + WS_QA),
                (bf16_t*)(ws + WS_QI), (bf16_t*)(ws + WS_KI), (float*)(ws + WS_WI), (LAS float*)(C.lds + EPI_OFF)};
    pg8::gemm_phase<EpiInProj, InProjOrder, true, true, true>(C.lds, g, S, E);
}
namespace at {
constexpr float SCALE = 0.08838834764831845f;
constexpr int NW = 8, QBLK = 32, KVBLK = 64, QB = NW * QBLK, DH = 128;
constexpr int PQ = 1024;
constexpr int PO = 2048;
constexpr int SHM_V = KVBLK * DH * 2, SHM_K = KVBLK * DH * 2;
constexpr int OFF_WS = 2 * SHM_V + 2 * SHM_K;
constexpr int OFF_BIAS = OFF_WS + NW * 64 * 4;
constexpr int OFF_Q = OFF_BIAS + 264 * 4;
constexpr int LDS_ATT = OFF_Q + NW * 8192;
constexpr float THR = 8.f;
#define KSWZ(row, colB) ((row) * 256 + ((colB) ^ (((row) & 7) << 4)))
#define SBAR() __builtin_amdgcn_sched_barrier(0)
__device__ __forceinline__ int v_st(int k, int c) { const int kk = (k & ~0xC) | ((k & 4) << 1) | ((k & 8) >> 1); return ((kk >> 3) * 4 + (c >> 5)) * 512 + ((kk & 7) * 32 + (c & 31)) * 2; }
__device__ __forceinline__ int v_rd_base(int lane) { return ((lane & 3) << 3) | (((lane >> 2) & 3) << 6) | (((lane >> 4) & 1) << 5) | (((lane >> 5) & 1) << 8); }
constexpr int v_rd_off(int d0, int ks, int half) { return d0 * 512 + ks * 4096 + half * 2048; }
__device__ __forceinline__ int crow(int r, int hi) { return (r & 3) + 8 * (r >> 2) + 4 * hi; }
__device__ __forceinline__ unsigned cvtpk(float lo, float hi) { unsigned r; asm volatile("v_cvt_pk_bf16_f32 %0, %1, %2" : "=v"(r) : "v"(lo), "v"(hi)); return r; }

__device__ __forceinline__ void partialSM(f32x16& p0, f32x16& p1, float& m_reg, float& mn, float& alpha) {
    constexpr float C2 = 1.4426950408889634f * SCALE;
    mn = m_reg; alpha = 1.f;
    const float mnL = -m_reg * C2;
#pragma unroll
    for (int r = 0; r < 16; ++r) p0[r] = fmaf(p0[r], C2, mnL);
#pragma unroll
    for (int r = 0; r < 16; ++r) p1[r] = fmaf(p1[r], C2, mnL);
#pragma unroll
    for (int r = 0; r < 16; ++r) p0[r] = __builtin_amdgcn_exp2f(p0[r]);
}
__device__ __forceinline__ void finishSM(f32x16& p0, f32x16& p1, float alpha, float& l_reg, bf16x8& pa0, bf16x8& pa1, bf16x8& pa2, bf16x8& pa3) {
#pragma unroll
    for (int r = 0; r < 16; ++r) p1[r] = __builtin_amdgcn_exp2f(p1[r]);
    float ps = 0;
#pragma unroll
    for (int r = 0; r < 16; ++r) ps += p0[r];
#pragma unroll
    for (int r = 0; r < 16; ++r) ps += p1[r];
    { auto rr = __builtin_amdgcn_permlane32_swap(__float_as_uint(ps), __float_as_uint(ps), false, false);
      ps = __uint_as_float(rr[0]) + __uint_as_float(rr[1]); }
    l_reg = l_reg * alpha + ps;
#define PK4(P, B_, OUT) do { unsigned a0 = cvtpk(P[B_+0], P[B_+1]), a1 = cvtpk(P[B_+2], P[B_+3]);                          \
        unsigned b0 = cvtpk(P[B_+4], P[B_+5]), b1 = cvtpk(P[B_+6], P[B_+7]);                                             \
        auto r0 = __builtin_amdgcn_permlane32_swap(a0, b0, false, false); auto r1 = __builtin_amdgcn_permlane32_swap(a1, b1, false, false); \
        u32x4 w = {r0[0], r1[0], r0[1], r1[1]}; OUT = *reinterpret_cast<bf16x8*>(&w); } while (0)
    PK4(p0, 0, pa0); PK4(p0, 8, pa1); PK4(p1, 0, pa2); PK4(p1, 8, pa3);
#undef PK4
}
template <int KB>
__device__ __forceinline__ void qkt(f32x16& p0, f32x16& p1, const char* K_lds, int r32, int hi, const char* qw, bool act) {
    if (!act) { const float NEG = -__builtin_inff();
#pragma unroll
        for (int r = 0; r < 16; ++r) { p0[r] = NEG; p1[r] = NEG; } return; }
    p0 = f32x16{}; p1 = f32x16{};
    const char* kb[4];
#pragma unroll
    for (int dd = 0; dd < 4; ++dd) kb[dd] = K_lds + KB * SHM_K + KSWZ(r32, (dd * 16 + hi * 8) * 2);
#pragma unroll
    for (int d0 = 0; d0 < 8; ++d0) { const char* a = kb[d0 & 3] + (d0 >> 2) * 128;
        bf16x8 b0 = *reinterpret_cast<const bf16x8*>(a);
        bf16x8 b1 = *reinterpret_cast<const bf16x8*>(a + 32 * 256);
        const bf16x8 qf = *reinterpret_cast<const bf16x8*>(qw + d0 * 1024);
        p0 = __builtin_amdgcn_mfma_f32_32x32x16_bf16(b0, qf, p0, 0, 0, 0);
        p1 = __builtin_amdgcn_mfma_f32_32x32x16_bf16(b1, qf, p1, 0, 0, 0); }
}
template <int VB>
__device__ __forceinline__ void pv_tile(f32x16* o, int vb0, bf16x8 pa0, bf16x8 pa1, bf16x8 pa2, bf16x8 pa3, bool act) {
    if (!act) return;
#define TRRD(dst, off) asm volatile("ds_read_b64_tr_b16 %0, %1 offset:%2" : "=&v"(dst) : "v"(vb0), "i"(off) : "memory")
#define PV_D0(d0) do { s16x4 l0, l1, l2, l3, h0, h1, h2, h3; constexpr int b_ = VB * SHM_V + v_rd_off(d0, 0, 0); \
        TRRD(l0, b_); TRRD(h0, b_ + 2048); TRRD(l1, b_ + 4096); TRRD(h1, b_ + 6144); TRRD(l2, b_ + 8192); TRRD(h2, b_ + 10240); TRRD(l3, b_ + 12288); TRRD(h3, b_ + 14336); \
        asm volatile("s_waitcnt lgkmcnt(0)" ::: "memory"); SBAR();   \
        o[d0] = __builtin_amdgcn_mfma_f32_32x32x16_bf16(pa0, (bf16x8){l0[0], l0[1], l0[2], l0[3], h0[0], h0[1], h0[2], h0[3]}, o[d0], 0, 0, 0);   \
        o[d0] = __builtin_amdgcn_mfma_f32_32x32x16_bf16(pa1, (bf16x8){l1[0], l1[1], l1[2], l1[3], h1[0], h1[1], h1[2], h1[3]}, o[d0], 0, 0, 0);   \
        o[d0] = __builtin_amdgcn_mfma_f32_32x32x16_bf16(pa2, (bf16x8){l2[0], l2[1], l2[2], l2[3], h2[0], h2[1], h2[2], h2[3]}, o[d0], 0, 0, 0);   \
        o[d0] = __builtin_amdgcn_mfma_f32_32x32x16_bf16(pa3, (bf16x8){l3[0], l3[1], l3[2], l3[3], h3[0], h3[1], h3[2], h3[3]}, o[d0], 0, 0, 0); } while (0)
    PV_D0(0); PV_D0(1); PV_D0(2); PV_D0(3);
#undef PV_D0
#undef TRRD
}

struct BlockRef { const bf16_t* Q; const bf16_t* K; const bf16_t* V; bf16_t* O; int qb; const float* gains;   const unsigned long long* bm;   const float* bias;   };
struct Seam { bf16x8 st_v0, st_v1, st_k0, st_k1; };

template <int MODE> __device__ __forceinline__ int blk_jlo(int qb) { return MODE == 0 ? (4 * qb - 8 > 0 ? 4 * qb - 8 : 0) : 0; }

#define ROW(p, k0, rr) ((p) + (size_t)((k0) + (rr)) * PQ + sc)
#define VMW() asm volatile("s_waitcnt vmcnt(0)" ::: "memory")
#define VMWN(n) asm volatile("s_waitcnt vmcnt(%0)" :: "i"(n) : "memory")
#define LD8(p) (*reinterpret_cast<const bf16x8*>(p))
#define SLOAD_H(Kp, Vp, k0) do { S.st_v0 = LD8(ROW(Vp, k0, sr)); S.st_v1 = LD8(ROW(Vp, k0, 32 + sr)); S.st_k0 = LD8(ROW(Kp, k0, sr)); S.st_k1 = LD8(ROW(Kp, k0, 32 + sr)); } while (0)
#define SWRITE_HK(bf) do { *(bf16x8*)(K_lds + (bf) * SHM_K + kws) = S.st_k0; *(bf16x8*)(K_lds + (bf) * SHM_K + kws + 32 * 256) = S.st_k1; } while (0)
#define SWRITE_HV(bf) do { *(bf16x8*)(V_lds + (bf) * SHM_V + vst0) = S.st_v0; *(bf16x8*)(V_lds + (bf) * SHM_V + vst1) = S.st_v1; } while (0)
#define SWRITE_H(bf) do { SWRITE_HV(bf); SWRITE_HK(bf); } while (0)

template <int MODE>
__device__ __forceinline__ void attn_prime(const BlockRef& cur, char* lds, Seam& S) {
    int tid_ = threadIdx.x; asm volatile("" : "+v"(tid_));
    const int tid = tid_, wid = __builtin_amdgcn_readfirstlane(tid >> 6), lane = tid & 63, r32 = lane & 31, hi = lane >> 5;
    const int sr = tid >> 4, sc = (tid & 15) * 8, kws = KSWZ(sr, sc * 2); char* K_lds = lds + 2 * SHM_V;
    const int kb0 = blk_jlo<MODE>(cur.qb) * KVBLK;
    (void)wid; (void)lane; (void)r32; (void)hi;
    SLOAD_H(cur.K, cur.V, kb0); VMW(); SWRITE_HK(0);
    __syncthreads();
}

template <int MODE>
__device__ __forceinline__ void attn_block(const BlockRef& cur, const BlockRef& nxt, char* lds, Seam& S) {
    int tid_ = threadIdx.x; asm volatile("" : "+v"(tid_));
    const int tid = tid_, wid = __builtin_amdgcn_readfirstlane(tid >> 6), lane = tid & 63, r32 = lane & 31, hi = lane >> 5;
    const int P0 = cur.qb * QB;
    const int j_lo = blk_jlo<MODE>(cur.qb), j_hi = 4 * cur.qb + 4;
    const int NT = j_hi - j_lo;
    const int kbn = blk_jlo<MODE>(nxt.qb) * KVBLK;
    const int qlo = P0 + wid * QBLK;
    const int cw = qlo >> 6;
    char* V_lds = lds; char* K_lds = lds + 2 * SHM_V;
    float* ws = (float*)(lds + OFF_WS) + wid * 64; float* li_l = ws, * al_l = ws + 32;
    float* btab = (float*)(lds + OFF_BIAS);
    float m_reg = 0.f, l_reg = 0; f32x16 o[4] = {};
    const int sr = tid >> 4, sc = (tid & 15) * 8, vst0 = v_st(sr, sc), vst1 = v_st(32 + sr, sc), kws = KSWZ(sr, sc * 2);
    const int vb0 = (int)(uintptr_t)V_lds + v_rd_base(lane);
    const bf16_t* Kh = cur.K; const bf16_t* Vh = cur.V;
    char* qw = lds + OFF_Q + wid * 8192 + lane * 16;
    {
        bf16x8 qt[8];
#pragma unroll
        for (int d0 = 0; d0 < 8; ++d0) qt[d0] = LD8(cur.Q + (size_t)(wid * QBLK + r32) * PQ + d0 * 16 + hi * 8);
#pragma unroll
        for (int d0 = 0; d0 < 8; ++d0) *reinterpret_cast<bf16x8*>(qw + d0 * 1024) = qt[d0];
    }
    if (MODE == 0) {
        if (tid < 257) btab[tid] = cur.bias[tid] * (1.0f / SCALE);
        __syncthreads();
    }
    {
        float gq = fmaxf(fabsf(cur.gains[lane]), fabsf(cur.gains[lane + 64])), gk = fmaxf(fabsf(cur.gains[128 + lane]), fabsf(cur.gains[192 + lane]));
        float bb = 0.f;
        if (MODE == 0) { for (int i = lane; i < 257; i += 64) bb = fmaxf(bb, fabsf(btab[i])); }
#pragma unroll
        for (int o_ = 1; o_ < 64; o_ <<= 1) { gq = fmaxf(gq, __shfl_xor(gq, o_)); gk = fmaxf(gk, __shfl_xor(gk, o_)); bb = fmaxf(bb, __shfl_xor(bb, o_)); }
        m_reg = (128.f * gq * gk + bb) * 1.01f;
    }
    const unsigned long long* bmrow = (MODE == 1) ? cur.bm + (size_t)(wid * QBLK + r32) * 64 : nullptr;
#define RESC(a) do { } while (0)
#define JC(t) (j_lo + (t))
#define KBASE(t) (JC(t) * KVBLK)
#define ACT(t) (MODE == 0 ? (JC(t) >= cw - 8 && JC(t) <= cw) : (JC(t) <= cw))
#define MODT(P0_, P1_, t) do { if (ACT(t)) { const int kb_ = KBASE(t);                                                                   \
        if (MODE == 0) {                                                                                                                   \
            if (kb_ + KVBLK - 1 + 128 <= qlo) { const float cb = btab[256];                                                               \
                _Pragma("unroll") for (int r = 0; r < 16; ++r) { P0_[r] += cb; P1_[r] += cb; } }                                          \
            else { int dq = qlo + r32 - kb_ - 4 * hi + 128; asm volatile("" : "+v"(dq));                                                  \
                _Pragma("unroll") for (int r = 0; r < 16; ++r) { const int c = (r & 3) + 8 * (r >> 2);                                     \
                    int i0 = dq - c, i1 = dq - c - 32; i0 = i0 < 0 ? 0 : (i0 > 256 ? 256 : i0); i1 = i1 < 0 ? 0 : (i1 > 256 ? 256 : i1); \
                    P0_[r] += btab[i0]; P1_[r] += btab[i1]; } }                                                                            \
        } else {                                                                                                                           \
            const unsigned long long w_ = mw;                                                                                              \
            unsigned lo_ = (unsigned)w_ >> (4 * hi), hi_ = (unsigned)(w_ >> 32) >> (4 * hi); const float NEG = -__builtin_inff();          \
            asm volatile("" : "+v"(lo_), "+v"(hi_));                                                                                         \
            _Pragma("unroll") for (int r = 0; r < 16; ++r) { const int c = (r & 3) + 8 * (r >> 2);                                         \
                if (!((lo_ >> c) & 1u)) P0_[r] = NEG; if (!((hi_ >> c) & 1u)) P1_[r] = NEG; } }                                            \
    } } while (0)
#define MLOAD(t) do { if (MODE == 1) mw = bmrow[JC(t)]; } while (0)
#define SEAM_K0() do { VMW(); SWRITE_HK(0); SBAR(); } while (0)
    f32x16 pA0, pA1, pB0, pB1; float mnA, mnB, alA, alB; bf16x8 pa0, pa1, pa2, pa3;
    unsigned long long mw = 0;
    SWRITE_HV(0); SBAR();
    if (NT > 1) SLOAD_H(Kh, Vh, KBASE(1));
    MLOAD(0);
    SBAR(); qkt<0>(pA0, pA1, K_lds, r32, hi, qw, ACT(0));
    MODT(pA0, pA1, 0); partialSM(pA0, pA1, m_reg, mnA, alA);
    if (NT > 1) { VMW(); SWRITE_H(1); }
    __syncthreads();
#define HALF_STEP(PX0, PX1, mnX, alX, PY0, PY1, alY, t, KB, VB, SB) do {                                                      \
        MLOAD(t);                                                                                                             \
        SBAR(); qkt<KB>(PX0, PX1, K_lds, r32, hi, qw, ACT(t));                                                              \
        finishSM(PY0, PY1, alY, l_reg, pa0, pa1, pa2, pa3); SBAR();                                                           \
        if ((t) + 1 < NT) { SLOAD_H(Kh, Vh, KBASE((t) + 1)); SBAR(); }                                                        \
        pv_tile<VB>(o, vb0, pa0, pa1, pa2, pa3, ACT((t) - 1)); MODT(PX0, PX1, (t)); partialSM(PX0, PX1, m_reg, mnX, alX);    \
        __syncthreads();                                                                                                      \
        if ((t) + 1 < NT) { VMW(); SWRITE_H(SB); }                                                                            \
        RESC(alX); __syncthreads(); } while (0)
    for (int t = 1; t + 1 < NT; t += 2) {
        HALF_STEP(pB0, pB1, mnB, alB, pA0, pA1, alA, t, 1, 0, 0);
        HALF_STEP(pA0, pA1, mnA, alA, pB0, pB1, alB, t + 1, 0, 1, 1);
    }
    const bool even = (NT & 1) == 0;
    if (even) { MLOAD(NT - 1); SBAR(); qkt<1>(pB0, pB1, K_lds, r32, hi, qw, ACT(NT - 1)); SBAR(); }
    SLOAD_H(nxt.K, nxt.V, kbn); SBAR();
    finishSM(pA0, pA1, alA, l_reg, pa0, pa1, pa2, pa3); SBAR();
    pv_tile<0>(o, vb0, pa0, pa1, pa2, pa3, ACT(even ? NT - 2 : NT - 1));
    if (even) { MODT(pB0, pB1, NT - 1); partialSM(pB0, pB1, m_reg, mnB, alB); __syncthreads(); RESC(alB);
        finishSM(pB0, pB1, alB, l_reg, pa0, pa1, pa2, pa3); SBAR(); pv_tile<1>(o, vb0, pa0, pa1, pa2, pa3, ACT(NT - 1)); }
    SBAR(); SEAM_K0();
    if (hi == 0) li_l[r32] = l_reg; asm volatile("s_waitcnt lgkmcnt(0)" ::: "memory");
    float rli[16];
#pragma unroll
    for (int r = 0; r < 16; ++r) rli[r] = __builtin_amdgcn_rcpf(li_l[crow(r, hi)]);
    bf16_t* Ow = cur.O + (size_t)(wid * QBLK) * PO;
#pragma unroll
    for (int r = 0; r < 16; ++r) { const int orow = crow(r, hi);
#pragma unroll
        for (int d0 = 0; d0 < 4; ++d0) { const float v = o[d0][r] * rli[r];
            const float vn = __shfl_xor(v, 1);
            if ((r32 & 1) == 0) *(unsigned*)(Ow + (size_t)orow * PO + d0 * 32 + r32) = cvtpk(v, vn); } }
    __syncthreads();
#undef RESC
#undef JC
#undef KBASE
#undef ACT
#undef MODT
#undef MLOAD
#undef SEAM_K0
#undef HALF_STEP
}
#undef ROW
#undef VMW
#undef VMWN
#undef LD8
#undef SLOAD_H
#undef SWRITE_HK
#undef SWRITE_HV
#undef SWRITE_H
#undef KSWZ
#undef SBAR
}
struct P2Item { int b, qt, kb; };
__device__ __forceinline__ P2Item p2_item(int L) {
    P2Item it; constexpr int PER_B = 1088;
    it.b = L / PER_B; int rem = L % PER_B; int j = 0; while (rem >= 8 * (j + 1)) { rem -= 8 * (j + 1); ++j; }
    it.qt = 8 * j + rem / (j + 1); it.kb = rem % (j + 1); return it;
}
__device__ __forceinline__ void p2_scores(const Ctx& C, const Args& a) {
    unsigned char* ws = a.ws;
    const bf16_t* QI = (const bf16_t*)(ws + WS_QI); const bf16_t* KI = (const bf16_t*)(ws + WS_KI); const float* WI = (const float*)(ws + WS_WI);
    float* SC = (float*)(ws + WS_SC);
    LAS unsigned char* lds = C.lds;
    constexpr int QB = 65536 + 2048;
    const int tid = C.tid, lane = C.lane, wid = C.wave, r = lane & 31, hh = lane >> 5;
    const int srow = tid >> 4, sc0 = tid & 15;
    constexpr int NITEM = 2 * 1088;
    u32x4 nq[8]; float nw = 0.f;
    int L = C.vcu, buf = 0;
    if (L < NITEM) {
        const P2Item it = p2_item(L); const int q0 = it.b * S + it.qt * 32;
#pragma unroll
        for (int i = 0; i < 8; ++i) nq[i] = *(const u32x4*)(QI + (size_t)(q0 + srow) * 1024 + (sc0 + 16 * i) * 8);
        nw = WI[(size_t)(q0 + srow) * 16 + sc0];
        __syncthreads();
#pragma unroll
        for (int i = 0; i < 8; ++i) { const int ch = sc0 + 16 * i; *(LAS u32x4*)(lds + srow * 2048 + ((ch ^ (srow & 15)) << 4)) = nq[i]; }
        ((LAS float*)(lds + 65536))[sc0 * 32 + srow] = nw;
        __syncthreads();
    }
    for (; L < NITEM; L += C.G) {
        const P2Item it = p2_item(L);
        const int q0 = it.b * S + it.qt * 32, nadm = (it.qt / 2 + 1) * 64, kbase = it.kb * 256 + wid * 32;
        const bool more = L + C.G < NITEM;
        if (more) {
            const P2Item nx = p2_item(L + C.G); const int qn = nx.b * S + nx.qt * 32;
#pragma unroll
            for (int i = 0; i < 8; ++i) nq[i] = *(const u32x4*)(QI + (size_t)(qn + srow) * 1024 + (sc0 + 16 * i) * 8);
            nw = WI[(size_t)(qn + srow) * 16 + sc0];
        }
        const LAS unsigned char* qb = lds + buf * QB;
        if (kbase < nadm) {
            bf16x8 bfrag[4];
#pragma unroll
            for (int ks = 0; ks < 4; ++ks) bfrag[ks] = *(const bf16x8*)(KI + (size_t)(it.b * S + kbase + r) * 64 + ks * 16 + hh * 8);
            f32x16 score = f32x16{};
#pragma unroll 4
            for (int h = 0; h < 16; ++h) {
                f32x16 acc = f32x16{};
#pragma unroll
                for (int ks = 0; ks < 4; ++ks) {
                    const int ch = h * 8 + 2 * ks + hh;
                    const bf16x8 af = *(const LAS bf16x8*)(qb + r * 2048 + ((ch ^ (r & 15)) << 4));
                    acc = __builtin_amdgcn_mfma_f32_32x32x16_bf16(af, bfrag[ks], acc, 0, 0, 0);
                }
                const LAS float* wf = (const LAS float*)(qb + 65536) + h * 32 + 4 * hh;
#pragma unroll
                for (int g = 0; g < 4; ++g) {
                    const f32x4 w4 = *(const LAS f32x4*)(wf + 8 * g);
                    score[4 * g + 0] = fmaf(w4.x, fmaxf(acc[4 * g + 0], 0.f), score[4 * g + 0]);
                    score[4 * g + 1] = fmaf(w4.y, fmaxf(acc[4 * g + 1], 0.f), score[4 * g + 1]);
                    score[4 * g + 2] = fmaf(w4.z, fmaxf(acc[4 * g + 2], 0.f), score[4 * g + 2]);
                    score[4 * g + 3] = fmaf(w4.w, fmaxf(acc[4 * g + 3], 0.f), score[4 * g + 3]);
                }
            }
            float* out = SC + (size_t)q0 * 4096 + kbase + r;
#pragma unroll
            for (int r16 = 0; r16 < 16; ++r16) out[(size_t)((r16 & 3) + 8 * (r16 >> 2) + 4 * hh) * 4096] = score[r16];
        }
        if (more) {
            LAS unsigned char* nb = lds + (buf ^ 1) * QB;
#pragma unroll
            for (int i = 0; i < 8; ++i) { const int ch = sc0 + 16 * i; *(LAS u32x4*)(nb + srow * 2048 + ((ch ^ (srow & 15)) << 4)) = nq[i]; }
            ((LAS float*)(nb + 65536))[sc0 * 32 + srow] = nw;
        }
        __syncthreads();
        buf ^= 1;
    }
}

__device__ __forceinline__ unsigned skey(float f) { const unsigned u = __builtin_bit_cast(unsigned, f); return (u & 0x80000000u) ? ~u : (u | 0x80000000u); }
__device__ __forceinline__ int wave_sum_i_dpp(int x) {
    x += __builtin_amdgcn_update_dpp(0, x, 0xB1, 0xF, 0xF, true);
    x += __builtin_amdgcn_update_dpp(0, x, 0x4E, 0xF, 0xF, true);
    x += __builtin_amdgcn_update_dpp(0, x, 0x141, 0xF, 0xF, true);
    x += __builtin_amdgcn_update_dpp(0, x, 0x140, 0xF, 0xF, true);
    return __builtin_amdgcn_readlane(x, 0) + __builtin_amdgcn_readlane(x, 16) + __builtin_amdgcn_readlane(x, 32) + __builtin_amdgcn_readlane(x, 48);
}
__device__ __forceinline__ float wave_max_f_dpp(float x) {
    x = fmaxf(x, __builtin_bit_cast(float, __builtin_amdgcn_update_dpp(0, __builtin_bit_cast(int, x), 0xB1, 0xF, 0xF, true)));
    x = fmaxf(x, __builtin_bit_cast(float, __builtin_amdgcn_update_dpp(0, __builtin_bit_cast(int, x), 0x4E, 0xF, 0xF, true)));
    x = fmaxf(x, __builtin_bit_cast(float, __builtin_amdgcn_update_dpp(0, __builtin_bit_cast(int, x), 0x141, 0xF, 0xF, true)));
    x = fmaxf(x, __builtin_bit_cast(float, __builtin_amdgcn_update_dpp(0, __builtin_bit_cast(int, x), 0x140, 0xF, 0xF, true)));
    const int xi = __builtin_bit_cast(int, x);
    return fmaxf(fmaxf(__builtin_bit_cast(float, __builtin_amdgcn_readlane(xi, 0)), __builtin_bit_cast(float, __builtin_amdgcn_readlane(xi, 16))),
                 fmaxf(__builtin_bit_cast(float, __builtin_amdgcn_readlane(xi, 32)), __builtin_bit_cast(float, __builtin_amdgcn_readlane(xi, 48))));
}
template <int NR, class SP>
__device__ __forceinline__ void p3_select_row(SP sr, int n64, unsigned long long* __restrict__ bmrow, int lane) {
    float v[NR];
#pragma unroll
    for (int i = 0; i < NR; ++i) v[i] = (i < n64) ? sr[64 * i] : -__builtin_inff();
    float thr = -__builtin_inff();
    if (n64 > TOPK / 64) {
        float mx = v[0], mn = v[0];
#pragma unroll
        for (int i = 1; i < NR; ++i) { mx = fmaxf(mx, v[i]); if (i < n64) mn = fminf(mn, v[i]); }
        float hi = wave_max_f_dpp(mx), lo = -wave_max_f_dpp(-mn);
        hi = __builtin_bit_cast(float, __builtin_bit_cast(int, hi) + (hi >= 0.f ? 1 : -1));
        thr = lo;
        for (int it = 0; it < 64; ++it) {
            const float mid = 0.5f * lo + 0.5f * hi;
            if (!(mid > lo) || !(mid < hi)) break;
            int c0 = 0, c1 = 0, c2 = 0, c3 = 0;
#pragma unroll
            for (int i = 0; i < NR; i += 4) {
                unsigned long long m0, m1, m2, m3;
                asm volatile("v_cmp_ge_f32_e64 %[m0], %[a0], %[md]\n\tv_cmp_ge_f32_e64 %[m1], %[a1], %[md]\n\tv_cmp_ge_f32_e64 %[m2], %[a2], %[md]\n\tv_cmp_ge_f32_e64 %[m3], %[a3], %[md]\n\t"
                             "v_addc_co_u32_e64 %[c0], %[m0], 0, %[c0], %[m0]\n\tv_addc_co_u32_e64 %[c1], %[m1], 0, %[c1], %[m1]\n\tv_addc_co_u32_e64 %[c2], %[m2], 0, %[c2], %[m2]\n\tv_addc_co_u32_e64 %[c3], %[m3], 0, %[c3], %[m3]"
                             : [c0] "+v"(c0), [c1] "+v"(c1), [c2] "+v"(c2), [c3] "+v"(c3), [m0] "=&s"(m0), [m1] "=&s"(m1), [m2] "=&s"(m2), [m3] "=&s"(m3)
                             : [a0] "v"(v[i]), [a1] "v"(v[i + 1]), [a2] "v"(v[i + 2]), [a3] "v"(v[i + 3]), [md] "v"(mid));
            }
            const int c = wave_sum_i_dpp((c0 + c1) + (c2 + c3));
            if (c >= TOPK) { lo = mid; thr = mid; } else hi = mid;
            if (c == TOPK) break;
        }
    }
    unsigned long long w = 0ull;
#pragma unroll
    for (int i = 0; i < NR; ++i) { const unsigned long long bb = __ballot((i < n64) && (v[i] >= thr)); if (lane == i) w = bb; }
    bmrow[lane] = w;
}
__device__ __forceinline__ void p3_select(const Ctx& C, const Args& a) {
    unsigned char* ws = a.ws;
    const float* SC = (const float*)(ws + WS_SC); unsigned long long* BM = (unsigned long long*)(ws + WS_BM);
    const int gw = C.vcu * NWAVES + C.wave, NGW = C.G * NWAVES, lane = C.lane;
    for (int row = gw; row < T; row += NGW) {
        const int s = row & (S - 1), n64 = (s >> 6) + 1;
        const float* sr = SC + (size_t)row * 4096 + lane;
        unsigned long long* bm = BM + (size_t)row * 64;
        if (n64 <= 16) p3_select_row<16, const float*>(sr, n64, bm, lane);
        else if (n64 <= 32) p3_select_row<32, const float*>(sr, n64, bm, lane);
        else if (n64 <= 48) p3_select_row<48, const float*>(sr, n64, bm, lane);
        else p3_select_row<64, const float*>(sr, n64, bm, lane);
    }
}

template <bool WAIT>
__device__ __forceinline__ void p23_index_select(const Ctx& C, const Args& a) {
    unsigned char* ws = a.ws;
    const bf16_t* QI = (const bf16_t*)(ws + WS_QI); const bf16_t* KI = (const bf16_t*)(ws + WS_KI); const float* WI = (const float*)(ws + WS_WI);
    unsigned long long* BM = (unsigned long long*)(ws + WS_BM);
    LAS float* rowbuf = (LAS float*)C.lds;
    LAS float* wq = (LAS float*)(C.lds + 131072);
    const int tid = C.tid, lane = C.lane, wid = C.wave, r = lane & 31, hh = lane >> 5;
    unsigned* qd = (unsigned*)(ws + WS_QCNT) + 64 * 17;
    LAS int* slot = (LAS int*)(C.lds + LDS_BYTES - 128);
    if (tid == 0) {
        if (WAIT) {
            const unsigned* dc = (const unsigned*)(ws + WS_QCNT) + 64 * 18;
            while (__hip_atomic_load(dc, __ATOMIC_RELAXED, __HIP_MEMORY_SCOPE_AGENT) < (unsigned)P1_IDX_TILES) __builtin_amdgcn_s_sleep(16);
            __builtin_amdgcn_fence(__ATOMIC_ACQUIRE, "agent");
        }
        *slot = (int)__hip_atomic_fetch_add(qd, 1u, __ATOMIC_RELAXED, __HIP_MEMORY_SCOPE_AGENT);
    }
    __syncthreads();
    int pcur = __builtin_amdgcn_readfirstlane(*slot);
#define P23_SUB(PI, B_, Q0_, N64_) do { const int pi_ = (PI); B_ = pi_ & 1; const int s0_ = (511 - (pi_ >> 1)) * 8; N64_ = (s0_ >> 6) + 1; Q0_ = B_ * S + s0_; } while (0)
#define P23_LOADA(DST, Q0_) do { _Pragma("unroll") for (int rt = 0; rt < 4; ++rt) { const int i_ = rt * 32 + r; \
        _Pragma("unroll") for (int ks = 0; ks < 4; ++ks) DST[rt][ks] = *(const bf16x8*)(QI + (size_t)((Q0_) + (i_ >> 4)) * 1024 + (i_ & 15) * 64 + ks * 16 + hh * 8); } } while (0)
#define P23_LOADB0(B_, N64_) do { if (wid < 2 * (N64_)) { _Pragma("unroll") for (int ks = 0; ks < 4; ++ks) bfrag[ks] = *(const bf16x8*)(KI + (size_t)((B_) * S + wid * 32 + r) * 64 + ks * 16 + hh * 8); } } while (0)
    bf16x8 afn[4][4], bfrag[4]; float wqn = 0.f;
    if (pcur < 1024) { int b0, q00, n0; P23_SUB(pcur, b0, q00, n0); P23_LOADA(afn, q00); P23_LOADB0(b0, n0); if (tid < 128) wqn = WI[(size_t)(q00 + (tid >> 4)) * 16 + (tid & 15)]; }
    while (pcur < 1024) {
        int b, q0, n64; P23_SUB(pcur, b, q0, n64);
        __syncthreads();
        if (tid < 128) wq[tid] = wqn;
        unsigned tk = 0u;
        if (tid == 0) tk = __hip_atomic_fetch_add(qd, 1u, __ATOMIC_RELAXED, __HIP_MEMORY_SCOPE_AGENT);
        bf16x8 afr[4][4];
#pragma unroll
        for (int rt = 0; rt < 4; ++rt)
#pragma unroll
            for (int ks = 0; ks < 4; ++ks) afr[rt][ks] = afn[rt][ks];
        __syncthreads();
        const int ntile = n64 * 2;
        for (int kt = wid; kt < ntile; kt += 8) {
            bf16x8 bcur[4];
#pragma unroll
            for (int ks = 0; ks < 4; ++ks) bcur[ks] = bfrag[ks];
            if (kt + 8 < ntile) {
#pragma unroll
                for (int ks = 0; ks < 4; ++ks) bfrag[ks] = *(const bf16x8*)(KI + (size_t)(b * S + (kt + 8) * 32 + r) * 64 + ks * 16 + hh * 8);
            }
#define P23_CHAIN(ACC, RT) do { ACC = f32x16{}; _Pragma("unroll") for (int ks = 0; ks < 4; ++ks) ACC = __builtin_amdgcn_mfma_f32_32x32x16_bf16(afr[RT][ks], bcur[ks], ACC, 0, 0, 0); } while (0)
#define RELU(x) __builtin_amdgcn_fmed3f((x), 0.f, pinf)
            const float pinf = 3.0e38f;
            f32x16 accs[2];
            P23_CHAIN(accs[0], 0);
#pragma unroll
            for (int rt = 0; rt < 4; ++rt) {
                if (rt < 3) P23_CHAIN(accs[(rt + 1) & 1], rt + 1);
                const f32x16 acc = accs[rt & 1];
                const LAS float* wp = wq + rt * 32 + 4 * hh;
                const f32x4 w0 = *(const LAS f32x4*)(wp), w1 = *(const LAS f32x4*)(wp + 8), w2 = *(const LAS f32x4*)(wp + 16), w3 = *(const LAS f32x4*)(wp + 24);
                float sA = w0.x * RELU(acc[0]); sA = fmaf(w0.y, RELU(acc[1]), sA); sA = fmaf(w0.z, RELU(acc[2]), sA); sA = fmaf(w0.w, RELU(acc[3]), sA);
                sA = fmaf(w1.x, RELU(acc[4]), sA); sA = fmaf(w1.y, RELU(acc[5]), sA); sA = fmaf(w1.z, RELU(acc[6]), sA); sA = fmaf(w1.w, RELU(acc[7]), sA);
                float sB = w2.x * RELU(acc[8]); sB = fmaf(w2.y, RELU(acc[9]), sB); sB = fmaf(w2.z, RELU(acc[10]), sB); sB = fmaf(w2.w, RELU(acc[11]), sB);
                sB = fmaf(w3.x, RELU(acc[12]), sB); sB = fmaf(w3.y, RELU(acc[13]), sB); sB = fmaf(w3.z, RELU(acc[14]), sB); sB = fmaf(w3.w, RELU(acc[15]), sB);
                const auto sw = __builtin_amdgcn_permlane32_swap(__float_as_uint(sA), __float_as_uint(sB), false, false);
                const float tot = __uint_as_float(sw[0]) + __uint_as_float(sw[1]);
                rowbuf[(2 * rt + hh) * 4096 + kt * 32 + r] = tot;
            }
#undef P23_CHAIN
#undef RELU
        }
        if (tid == 0) *slot = (int)tk;
        __syncthreads();
        const int pnext = __builtin_amdgcn_readfirstlane(*slot);
        if (pnext < 1024) { int bn, qn, nn; P23_SUB(pnext, bn, qn, nn); P23_LOADA(afn, qn); P23_LOADB0(bn, nn); if (tid < 128) wqn = WI[(size_t)(qn + (tid >> 4)) * 16 + (tid & 15)]; }
        {
            const LAS float* sr = rowbuf + wid * 4096 + lane;
            unsigned long long* bm = BM + (size_t)(q0 + wid) * 64;
            if (n64 <= 16) p3_select_row<16, const LAS float*>(sr, n64, bm, lane);
            else if (n64 <= 32) p3_select_row<32, const LAS float*>(sr, n64, bm, lane);
            else if (n64 <= 48) p3_select_row<48, const LAS float*>(sr, n64, bm, lane);
            else p3_select_row<64, const LAS float*>(sr, n64, bm, lane);
        }
        pcur = pnext;
    }
#undef P23_SUB
#undef P23_LOADA
#undef P23_LOADB0
}

__device__ __forceinline__ at::BlockRef ref_dsa(unsigned char* ws, const float* gains, int b, int h, int qb) {
    at::BlockRef r; const size_t row0 = (size_t)b * S + (size_t)qb * 256;
    r.Q = (const bf16_t*)(ws + WS_QB) + row0 * 1024 + h * 128;
    r.K = (const bf16_t*)(ws + WS_KB) + (size_t)b * S * 1024 + h * 128;
    r.V = (const bf16_t*)(ws + WS_VBB) + (size_t)b * S * 1024 + h * 128;
    r.O = (bf16_t*)(ws + WS_O) + row0 * 2048 + 1024 + h * 128;
    r.qb = qb; r.gains = gains; r.bm = (const unsigned long long*)(ws + WS_BM) + row0 * 64; r.bias = nullptr;
    return r;
}
__device__ __forceinline__ at::BlockRef ref_mixa(unsigned char* ws, const float* rel_bias, const float* gains, int b, int h, int qb) {
    at::BlockRef r; const size_t row0 = (size_t)b * S + (size_t)qb * 256;
    r.Q = (const bf16_t*)(ws + WS_QA) + row0 * 1024 + h * 128;
    r.K = (const bf16_t*)(ws + WS_KA) + (size_t)b * S * 1024 + h * 128;
    r.V = (const bf16_t*)(ws + WS_VA) + (size_t)b * S * 1024 + h * 128;
    r.O = (bf16_t*)(ws + WS_O) + row0 * 2048 + h * 128;
    r.qb = qb; r.gains = gains; r.bm = nullptr; r.bias = rel_bias + h * 257;
    return r;
}
__device__ __forceinline__ void p4_attention(const Ctx& C, const Args& a, char* lds) {
    unsigned char* ws = a.ws;
    for (int v = C.bid; v < 256; v += C.G) {
        const int xcd = v & 7, slot = v >> 3;
        const int bh = 2 * xcd + (slot & 1), g = slot >> 1;
        const int b = bh >> 3, h = bh & 7;
        {
            at::Seam S;
            const at::BlockRef cur = ref_dsa(ws, a.in[6], b, h, 15 - g);
            at::attn_prime<1>(cur, lds, S);
            at::attn_block<1>(cur, cur, lds, S);
        }
        int q0 = 0, q1 = -1;
        if (g == 15) { q0 = 0; q1 = 4; } else if (g == 14) { q0 = 5; q1 = 8; } else if (g == 13) { q0 = 9; q1 = 12; } else if (g == 12) { q0 = 13; q1 = 15; }
        if (q0 <= q1) {
            at::Seam S;
            at::BlockRef cur = ref_mixa(ws, a.in[7], a.in[5], b, h, q0);
            at::attn_prime<0>(cur, lds, S);
            for (int qb = q0; qb <= q1; ++qb) {
                const at::BlockRef nxt = (qb < q1) ? ref_mixa(ws, a.in[7], a.in[5], b, h, qb + 1) : cur;
                at::attn_block<0>(cur, nxt, lds, S);
                cur = nxt;
            }
        }
    }
    {
        unsigned* qd = (unsigned*)(ws + WS_QCNT) + 64 * 16;
        LAS int* slot = (LAS int*)(C.lds + LDS_BYTES - 128);
        for (;;) {
            __syncthreads();
            if (C.tid == 0) *slot = (int)__hip_atomic_fetch_add(qd, 1u, __ATOMIC_RELAXED, __HIP_MEMORY_SCOPE_AGENT);
            __syncthreads();
            const int task = *slot;
            if (task >= DT_N) break;
            p0_task(C, a, task);
        }
    }
}
struct EpiOutProj {
    static constexpr bool PERM = false, AFTER_DRAIN = false;
    const bf16_t* xb; bf16_t* h1b;
    __device__ __forceinline__ void operator()(const f32x4 (&acc)[2][2][4][2], const pg8::Unit& u, int wr, int wc, int fr, int fq) const {
        const int row0 = u.pm * 256 + wr * 64 + fr, col0 = u.pn * 256 + wc * 32 + 4 * fq;
#pragma unroll
        for (int ai = 0; ai < 2; ++ai)
#pragma unroll
            for (int m = 0; m < 4; ++m) {
                const size_t ro = (size_t)(row0 + ai * 128 + m * 16) * D + col0;
#pragma unroll
                for (int bj = 0; bj < 2; ++bj)
#pragma unroll
                    for (int n = 0; n < 2; ++n) {
                        const size_t o = ro + bj * 128 + n * 16;
                        const u32x2 xw = *(const u32x2*)(xb + o);
                        f32x4 v = acc[ai][bj][m][n];
                        v.x += __builtin_bit_cast(float, xw.x << 16); v.y += __builtin_bit_cast(float, xw.x & 0xffff0000u);
                        v.z += __builtin_bit_cast(float, xw.y << 16); v.w += __builtin_bit_cast(float, xw.y & 0xffff0000u);
                        u32x2 w; w.x = pk2(v.x, v.y); w.y = pk2(v.z, v.w);
                        *(u32x2*)(h1b + o) = w;
                    }
            }
    }
};
struct EpiBf16Plain {
    static constexpr bool PERM = false, AFTER_DRAIN = false;
    bf16_t* O; int ldc;
    __device__ __forceinline__ void operator()(const f32x4 (&acc)[2][2][4][2], const pg8::Unit& u, int wr, int wc, int fr, int fq) const {
        const int row0 = u.pm * 256 + wr * 64 + fr, col0 = u.pn * 256 + wc * 32 + 4 * fq;
#pragma unroll
        for (int ai = 0; ai < 2; ++ai)
#pragma unroll
            for (int m = 0; m < 4; ++m) {
                const size_t ro = (size_t)(row0 + ai * 128 + m * 16) * ldc + col0;
#pragma unroll
                for (int bj = 0; bj < 2; ++bj)
#pragma unroll
                    for (int n = 0; n < 2; ++n) {
                        const f32x4 v = acc[ai][bj][m][n];
                        u32x2 w; w.x = pk2(v.x, v.y); w.y = pk2(v.z, v.w);
                        *(u32x2*)(O + ro + bj * 128 + n * 16) = w;
                    }
            }
    }
};
struct EpiBf16I8 {
    static constexpr bool PERM = false, AFTER_DRAIN = false;
    bf16_t* O; int ldc; const float* sa; const float* sw;
    __device__ __forceinline__ void operator()(const pg8::i32x4 (&acc)[2][2][4][2], const pg8::Unit& u, int wr, int wc, int fr, int fq) const {
        const int row0 = u.pm * 256 + wr * 64 + fr, col0 = u.pn * 256 + wc * 32 + 4 * fq;
        f32x4 swv[2][2];
#pragma unroll
        for (int bj = 0; bj < 2; ++bj)
#pragma unroll
            for (int n = 0; n < 2; ++n) swv[bj][n] = *(const f32x4*)(sw + col0 + bj * 128 + n * 16);
#pragma unroll
        for (int ai = 0; ai < 2; ++ai)
#pragma unroll
            for (int m = 0; m < 4; ++m) {
                const int row = row0 + ai * 128 + m * 16;
                const size_t ro = (size_t)row * ldc + col0; const float sar = sa[row];
#pragma unroll
                for (int bj = 0; bj < 2; ++bj)
#pragma unroll
                    for (int n = 0; n < 2; ++n) {
                        const f32x4 v = __builtin_convertvector(acc[ai][bj][m][n], f32x4) * swv[bj][n] * sar;
                        u32x2 w; w.x = pk2(v.x, v.y); w.y = pk2(v.z, v.w);
                        *(u32x2*)(O + ro + bj * 128 + n * 16) = w;
                    }
            }
    }
};
struct EpiF32Plain {
    static constexpr bool PERM = false, AFTER_DRAIN = false;
    float* Cp; int ldc;
    __device__ __forceinline__ void operator()(const f32x4 (&acc)[2][2][4][2], const pg8::Unit& u, int wr, int wc, int fr, int fq) const {
        const int row0 = u.pm * 256 + wr * 64 + fr, col0 = u.pn * 256 + wc * 32 + 4 * fq;
#pragma unroll
        for (int ai = 0; ai < 2; ++ai)
#pragma unroll
            for (int m = 0; m < 4; ++m) {
                const size_t ro = (size_t)(row0 + ai * 128 + m * 16) * ldc + col0;
#pragma unroll
                for (int bj = 0; bj < 2; ++bj)
#pragma unroll
                    for (int n = 0; n < 2; ++n) *(f32x4*)(Cp + ro + bj * 128 + n * 16) = acc[ai][bj][m][n];
            }
    }
};
struct EpiPle {
    static constexpr bool PERM = false, AFTER_DRAIN = false;
    const float* rs3; const bf16_t* pp; const bf16_t* h2b; float* out; const float* sa; const float* sw;
    __device__ __forceinline__ void operator()(const pg8::i32x4 (&acc)[2][2][4][2], const pg8::Unit& u, int wr, int wc, int fr, int fq) const {
        const int row0 = u.pm * 256 + wr * 64 + fr, col0 = u.pn * 256 + wc * 32 + 4 * fq;
        f32x4 swv[2][2];
#pragma unroll
        for (int bj = 0; bj < 2; ++bj)
#pragma unroll
            for (int n = 0; n < 2; ++n) swv[bj][n] = *(const f32x4*)(sw + col0 + bj * 128 + n * 16);
#pragma unroll
        for (int ai = 0; ai < 2; ++ai)
#pragma unroll
            for (int m = 0; m < 4; ++m) {
                const int row = row0 + ai * 128 + m * 16;
                const f32x4 q0 = *(const f32x4*)(rs3 + (size_t)row * 8), q1 = *(const f32x4*)(rs3 + (size_t)row * 8 + 4);
                const float r = rsqrtf(((q0.x + q0.y) + (q0.z + q0.w) + (q1.x + q1.y) + (q1.z + q1.w)) * (1.0f / D) + EPS) * -1.4426950408889634f * sa[row];
                const size_t ro = (size_t)row * D + col0;
#pragma unroll
                for (int bj = 0; bj < 2; ++bj)
#pragma unroll
                    for (int n = 0; n < 2; ++n) {
                        const size_t o = ro + bj * 128 + n * 16;
                        const f32x4 a4 = __builtin_convertvector(acc[ai][bj][m][n], f32x4) * swv[bj][n]; const u32x2 qw = *(const u32x2*)(pp + o), hw = *(const u32x2*)(h2b + o);
                        f32x4 h;
                        h.x = __builtin_bit_cast(float, hw.x << 16) + __builtin_bit_cast(float, qw.x << 16) * __builtin_amdgcn_rcpf(1.0f + __builtin_amdgcn_exp2f(a4.x * r));
                        h.y = __builtin_bit_cast(float, hw.x & 0xffff0000u) + __builtin_bit_cast(float, qw.x & 0xffff0000u) * __builtin_amdgcn_rcpf(1.0f + __builtin_amdgcn_exp2f(a4.y * r));
                        h.z = __builtin_bit_cast(float, hw.y << 16) + __builtin_bit_cast(float, qw.y << 16) * __builtin_amdgcn_rcpf(1.0f + __builtin_amdgcn_exp2f(a4.z * r));
                        h.w = __builtin_bit_cast(float, hw.y & 0xffff0000u) + __builtin_bit_cast(float, qw.y & 0xffff0000u) * __builtin_amdgcn_rcpf(1.0f + __builtin_amdgcn_exp2f(a4.w * r));
                        *(f32x4*)(out + o) = h;
                    }
            }
    }
};
constexpr size_t WS_QV = 288 * MiB;

__device__ __forceinline__ void p5_outproj(const Ctx& C, const Args& a) {
    unsigned char* ws = a.ws;
    pg8::Gemm g{(const bf16_t*)(ws + WS_O), (const bf16_t*)(ws + WS_WOUT), T, D, D};
    pg8::StaticOrder S; S.init(T, D, C.G, C.bid);
    EpiOutProj E{(const bf16_t*)(ws + WS_XB), (bf16_t*)(ws + WS_H1B)};
    pg8::gemm_phase<EpiOutProj, pg8::StaticOrder, true, true>(C.lds, g, S, E);
}
__device__ __forceinline__ void p5b_tokprep(const Ctx& C, const Args& a) {
    unsigned char* ws = a.ws;
    const int lane = C.lane, gw = C.vcu * NWAVES + C.wave, NGW = C.G * NWAVES;
    for (int t = gw; t < T; t += NGW) {
        const bf16_t* h1r = (const bf16_t*)(ws + WS_H1B) + (size_t)t * D + lane * 16;
        f32x4 x[8];
        float ss = 0.f;
#pragma unroll
        for (int j = 0; j < 2; ++j)
#pragma unroll
            for (int q = 0; q < 2; ++q) { const u32x4 w = *(const u32x4*)(h1r + 1024 * j + 8 * q);
                x[4 * j + 2 * q] = (f32x4){__builtin_bit_cast(float, w.x << 16), __builtin_bit_cast(float, w.x & 0xffff0000u), __builtin_bit_cast(float, w.y << 16), __builtin_bit_cast(float, w.y & 0xffff0000u)};
                x[4 * j + 2 * q + 1] = (f32x4){__builtin_bit_cast(float, w.z << 16), __builtin_bit_cast(float, w.z & 0xffff0000u), __builtin_bit_cast(float, w.w << 16), __builtin_bit_cast(float, w.w & 0xffff0000u)}; }
#pragma unroll
        for (int j = 0; j < 8; ++j) ss += (x[j].x * x[j].x + x[j].y * x[j].y) + (x[j].z * x[j].z + x[j].w * x[j].w);
        const float rs2 = rsqrtf(wave_sum(ss) * (1.0f / D) + EPS);
        {
            float mh = 0.f;
#pragma unroll
            for (int j = 0; j < 8; ++j) mh = fmaxf(fmaxf(mh, fmaxf(fabsf(x[j].x), fabsf(x[j].y))), fmaxf(fabsf(x[j].z), fabsf(x[j].w)));
#pragma unroll
            for (int o = 1; o < 64; o <<= 1) mh = fmaxf(mh, __shfl_xor(mh, o));
            if (lane == 0) ((float*)(ws + WS_AMAX1))[t] = mh;
        }
        const float* gf = a.in[9] + lane * 16;
        f32x4 y[8]; float mx = 0.f;
#pragma unroll
        for (int j = 0; j < 2; ++j)
#pragma unroll
            for (int q = 0; q < 4; ++q) { const f32x4 g4 = *(const f32x4*)(gf + 1024 * j + 4 * q); const f32x4 yy = x[4 * j + q] * g4 * rs2; y[4 * j + q] = yy;
                mx = fmaxf(fmaxf(mx, fmaxf(fabsf(yy.x), fabsf(yy.y))), fmaxf(fabsf(yy.z), fabsf(yy.w))); }
#pragma unroll
        for (int o = 1; o < 64; o <<= 1) mx = fmaxf(mx, __shfl_xor(mx, o));
        const float inv = mx > 0.f ? 127.0f / mx : 0.f;
        if (lane == 0) ((float*)(ws + WS_SX))[t] = mx * (1.0f / 127.0f);
        unsigned xw[8];
#pragma unroll
        for (int i = 0; i < 8; ++i)
            xw[i] = ((unsigned)(int)rintf(y[i].x * inv) & 0xffu) | (((unsigned)(int)rintf(y[i].y * inv) & 0xffu) << 8) | (((unsigned)(int)rintf(y[i].z * inv) & 0xffu) << 16) | (((unsigned)(int)rintf(y[i].w * inv) & 0xffu) << 24);
        unsigned char* xo = ws + WS_X8 + (size_t)t * D + lane * 16;
        u32x4 w0 = {xw[0], xw[1], xw[2], xw[3]}, w1 = {xw[4], xw[5], xw[6], xw[7]};
        *(u32x4*)xo = w0; *(u32x4*)(xo + 1024) = w1;
    }
}
__device__ __forceinline__ void p6_peerq_pp(const Ctx& C, const Args& a, bool pp_part) {
    unsigned char* ws = a.ws;
    if (!pp_part) {
        pg8::Gemm g{(const bf16_t*)(ws + WS_X8), (const bf16_t*)(ws + WS_WPQ8), T, D, D / 2};
        pg8::StaticOrder S; S.init(T, D, C.G, C.bid);
        EpiBf16I8 E{(bf16_t*)(ws + WS_QV), D, (const float*)(ws + WS_SX), (const float*)(ws + WS_SWPQ)};
        pg8::gemm_phase<EpiBf16I8, pg8::StaticOrder, true, true, true>(C.lds, g, S, E);
    } else {
        pg8::Gemm g{(const bf16_t*)(ws + WS_PB), (const bf16_t*)(ws + WS_WP), T, D, PLE};
        pg8::StaticOrder S; S.init(T, D, C.G, C.bid);
        EpiBf16Plain E{(bf16_t*)(ws + WS_PP), D};
        pg8::gemm_phase<EpiBf16Plain, pg8::StaticOrder, true, true>(C.lds, g, S, E);
    }
}
__device__ __forceinline__ void p8_quant_h2(const Ctx& C, const Args& a) {
    unsigned char* ws = a.ws;
    const int gw = C.vcu * NWAVES + C.wave, NGW = C.G * NWAVES;
    for (int m = gw; m < T; m += NGW) p0_quant_row((const bf16_t*)(ws + WS_XB) + (size_t)m * D, ws + WS_H2Q + (size_t)m * D, (float*)(ws + WS_SAH2) + m, C.lane);
}
__device__ __forceinline__ void p8_ple(const Ctx& C, const Args& a) {
    unsigned char* ws = a.ws;
    pg8::Gemm g{(const bf16_t*)(ws + WS_H2Q), (const bf16_t*)(ws + WS_WG8), T, D, D / 2};
    pg8::StaticOrder S; S.init(T, D, C.G, C.bid);
    EpiPle E{(const float*)(ws + WS_SSQP), (const bf16_t*)(ws + WS_PP), (const bf16_t*)(ws + WS_XB), a.out, (const float*)(ws + WS_SAH2), (const float*)(ws + WS_SWG)};
    pg8::gemm_phase<EpiPle, pg8::StaticOrder, true, true, true>(C.lds, g, S, E);
}

#define CE_DESC(x, y) do { const unsigned _mx = (x) > (y) ? (x) : (y), _mn = (x) > (y) ? (y) : (x); (x) = _mx; (y) = _mn; } while (0)
#define CE_ASC(x, y)  do { const unsigned _mx = (x) > (y) ? (x) : (y), _mn = (x) > (y) ? (y) : (x); (x) = _mn; (y) = _mx; } while (0)
__device__ __forceinline__ void sort16_desc(unsigned (&v)[16]) {
#pragma unroll
    for (int k = 2; k <= 16; k <<= 1)
#pragma unroll
        for (int j = k >> 1; j > 0; j >>= 1)
#pragma unroll
            for (int i = 0; i < 16; ++i) { const int l = i ^ j; if (l > i) { if ((i & k) == 0) CE_DESC(v[i], v[l]); else CE_ASC(v[i], v[l]); } }
}
__device__ __forceinline__ void merge_top16(unsigned (&a)[16], const unsigned (&b)[16]) {
#pragma unroll
    for (int i = 0; i < 16; ++i) a[i] = a[i] > b[15 - i] ? a[i] : b[15 - i];
#pragma unroll
    for (int j = 8; j > 0; j >>= 1)
#pragma unroll
        for (int i = 0; i < 16; ++i) { const int l = i ^ j; if (l > i) CE_DESC(a[i], a[l]); }
}
__device__ __forceinline__ void top16_of_64(unsigned (&g0)[16], unsigned (&g1)[16], unsigned (&g2)[16], unsigned (&g3)[16]) {
    sort16_desc(g0); sort16_desc(g1); sort16_desc(g2); sort16_desc(g3);
    merge_top16(g0, g1); merge_top16(g2, g3); merge_top16(g0, g2);
}
__device__ __forceinline__ unsigned skey_u(unsigned u) { return u ^ ((unsigned)((int)u >> 31) | 0x80000000u); }
__device__ __forceinline__ float unskey_f(unsigned k) { const unsigned u = (k & 0x80000000u) ? (k & 0x7fffffffu) : ~k; return __builtin_bit_cast(float, u); }
__device__ __forceinline__ float gelu_tanh_f(float x) {
    const float u = 0.7978845608028654f * (x + 0.044715f * x * x * x);
    const float e = __builtin_amdgcn_exp2f(u * 2.885390081777927f);
    const float th = 1.0f - 2.0f * __builtin_amdgcn_rcpf(e + 1.0f);
    return 0.5f * x * (1.0f + th);
}
typedef __bf16 bf16x2_t __attribute__((ext_vector_type(2)));
__device__ __forceinline__ float dot2bf(unsigned a, unsigned b, float c) { return __builtin_amdgcn_fdot2_f32_bf16(__builtin_bit_cast(bf16x2_t, a), __builtin_bit_cast(bf16x2_t, b), c, false); }

__device__ __forceinline__ void p7a_route(const Ctx& C, const Args& a, bool tile_mode, int pm, int pn) {
    unsigned char* ws = a.ws;
    LAS unsigned char* lds = C.lds;
    constexpr int OFF_SK = 0, OFF_EXP = 65536, OFF_SCS = 81920, OFF_TAB = 98304, OFF_CF = 131072;
    const int tid = C.tid, lane = C.lane, wid = C.wave, r32 = lane & 31, hi = lane >> 5;
    const bf16_t* QV = (const bf16_t*)(ws + WS_QV);
    __syncthreads();
    {
        const u32x4* src = (const u32x4*)(ws + WS_SUBK);
#pragma unroll
        for (int i = 0; i < 8; ++i) { const int c = tid + 512 * i, row = c >> 4, ch = c & 15; *(LAS u32x4*)(lds + OFF_SK + row * 256 + ((ch ^ (row & 15)) << 4)) = src[c]; }
    }
    __syncthreads();
    for (int blk = tile_mode ? 0 : C.vcu; blk < (tile_mode ? 1 : T / 32); blk += C.G) {
        const int t0 = tile_mode ? pm * 256 + 32 * wid : blk * 32;
        {
            const int h = tile_mode ? pn : wid;
            LAS unsigned* tab = (LAS unsigned*)(lds + OFF_TAB + wid * 4096 + r32 * 128);
#pragma unroll
            for (int half = 0; half < 2; ++half) {
                f32x16 acc[4]; acc[0] = f32x16{}; acc[1] = f32x16{}; acc[2] = f32x16{}; acc[3] = f32x16{};
                const bf16_t* qp = QV + (size_t)(t0 + r32) * 2048 + h * 256 + half * 128 + hi * 8;
#pragma unroll 2
                for (int ks = 0; ks < 8; ++ks) {
                    const bf16x8 qf = *(const bf16x8*)(qp + ks * 16);
#pragma unroll
                    for (int kt = 0; kt < 4; ++kt) {
                        const int row = half * 128 + kt * 32 + r32, ch = ks * 2 + hi;
#ifdef P7_SK_GLOBAL
                        const bf16x8 af = *(const bf16x8*)((const bf16_t*)(ws + WS_SUBK) + (size_t)row * 128 + ch * 8);
#else
                        const bf16x8 af = *(const LAS bf16x8*)(lds + OFF_SK + row * 256 + ((ch ^ (row & 15)) << 4));
#endif
                        acc[kt] = __builtin_amdgcn_mfma_f32_32x32x16_bf16(af, qf, acc[kt], 0, 0, 0);
                    }
                }
#ifdef P7_DEBUG_SCORE
                if (hi == 0) { float* dbf = (float*)(ws + WS_GATE) + ((size_t)(t0 + r32) * 8 + h) * 4 + half * 2; dbf[0] = acc[0][0]; dbf[1] = acc[3][15]; }
#endif
                unsigned hi4 = (unsigned)hi << 2; asm volatile("" : "+v"(hi4));
                unsigned g0[16], g1[16], g2[16], g3[16];
#pragma unroll
                for (int r = 0; r < 16; ++r) {
                    const unsigned base = (unsigned)((r & 3) + 8 * (r >> 2));
                    { const float sv = acc[0][r]; g0[r] = ((skey_u(__float_as_uint(sv)) & ~127u) | ((base + 0u) ^ 127u)) ^ hi4; }
                    { const float sv = acc[1][r]; g1[r] = ((skey_u(__float_as_uint(sv)) & ~127u) | ((base + 32u) ^ 127u)) ^ hi4; }
                    { const float sv = acc[2][r]; g2[r] = ((skey_u(__float_as_uint(sv)) & ~127u) | ((base + 64u) ^ 127u)) ^ hi4; }
                    { const float sv = acc[3][r]; g3[r] = ((skey_u(__float_as_uint(sv)) & ~127u) | ((base + 96u) ^ 127u)) ^ hi4; }
                }
#ifdef P7_SLOW_SORT
                { unsigned outl[16];
#pragma unroll
                  for (int it = 0; it < 16; ++it) { unsigned m = 0u;
#pragma unroll
                      for (int i = 0; i < 16; ++i) { m = m > g0[i] ? m : g0[i]; m = m > g1[i] ? m : g1[i]; m = m > g2[i] ? m : g2[i]; m = m > g3[i] ? m : g3[i]; }
                      outl[it] = m;
#pragma unroll
                      for (int i = 0; i < 16; ++i) { g0[i] = g0[i] == m ? 0u : g0[i]; g1[i] = g1[i] == m ? 0u : g1[i]; g2[i] = g2[i] == m ? 0u : g2[i]; g3[i] = g3[i] == m ? 0u : g3[i]; } }
#pragma unroll
                  for (int i = 0; i < 16; ++i) g0[i] = outl[i]; }
#else
                top16_of_64(g0, g1, g2, g3);
#endif
#ifdef P7_DEBUG_TOP1
                { unsigned* dbg = (unsigned*)(ws + WS_EXP) + ((size_t)(t0 + r32) * 8 + h) * 32 + half * 16;
#pragma unroll
                  for (int i = 0; i < 8; ++i) dbg[hi * 8 + i] = g0[i]; }
#endif
                unsigned pa[16], pb[16];
#pragma unroll
                for (int i = 0; i < 16; ++i) { auto rr = __builtin_amdgcn_permlane32_swap(g0[i], g0[i], false, false); pa[i] = rr[0]; pb[i] = rr[1]; }
                merge_top16(pa, pb);
                if (hi == 0) {
#pragma unroll
                    for (int i = 0; i < 16; ++i) tab[half * 16 + i] = pa[i];
                }
#ifdef P7_DEBUG_LISTS
                if (hi == 0) { unsigned* dbg = (unsigned*)(ws + WS_EXP) + ((size_t)(t0 + r32) * 8 + h) * 32 + half * 16;
#pragma unroll
                    for (int i = 0; i < 16; ++i) dbg[i] = pa[i]; }
#endif
                asm volatile("s_waitcnt lgkmcnt(0)" ::: "memory");
                __builtin_amdgcn_sched_barrier(0);
            }
            float f1[16], f2[16];
#pragma unroll
            for (int i = 0; i < 16; ++i) { f1[i] = unskey_f(tab[i] & ~127u); f2[i] = unskey_f(tab[16 + i] & ~127u); }
            unsigned c0[16], c1[16], c2[16], c3[16];
            {
                int cnt = 0;
#pragma unroll
                for (int aa = 0; aa < 16; ++aa)
#pragma unroll
                    for (int bb = 0; bb < 16; ++bb)
                        if ((aa + 1) * (bb + 1) <= 16) {
                            const float sm = f1[aa] + f2[bb];
                            const unsigned pk = (skey_u(__builtin_bit_cast(unsigned, sm)) & ~255u) | (255u - (unsigned)(aa * 16 + bb));
                            const int slot = cnt++;
                            if (slot < 16) c0[slot & 15] = pk; else if (slot < 32) c1[slot & 15] = pk; else if (slot < 48) c2[slot & 15] = pk; else c3[slot & 15] = pk;
                        }
#pragma unroll
                for (int s2 = 2; s2 < 16; ++s2) c3[s2] = 0u;
            }
            top16_of_64(c0, c1, c2, c3);
            asm volatile("s_waitcnt lgkmcnt(0)" ::: "memory");
            if (hi == 0) {
                float gsc[16]; float sm = 0.f;
                const float m0 = unskey_f(c0[0] & ~255u);
#pragma unroll
                for (int i = 0; i < 16; ++i) { gsc[i] = __builtin_amdgcn_exp2f((unskey_f(c0[i] & ~255u) - m0) * 1.4426950408889634f); sm += gsc[i]; }
                const float rsm = 1.0f / sm;
                int eid[16];
#pragma unroll
                for (int i = 0; i < 16; ++i) {
                    const unsigned ci = 255u - (c0[i] & 255u);
                    const unsigned e1 = 127u - (tab[ci >> 4] & 127u), e2 = 127u - (tab[16 + (ci & 15u)] & 127u);
                    eid[i] = (int)(e1 * 128u + e2);
                }
                float* gp = (float*)(ws + WS_GATE) + (size_t)(t0 + r32) * 128 + h * 16; int* ep = (int*)(ws + WS_EXP) + (size_t)(t0 + r32) * 128 + h * 16;
#pragma unroll
                for (int i = 0; i < 4; ++i) {
                    *(f32x4*)(gp + 4 * i) = (f32x4){gsc[4 * i] * rsm, gsc[4 * i + 1] * rsm, gsc[4 * i + 2] * rsm, gsc[4 * i + 3] * rsm};
                    *(u32x4*)(ep + 4 * i) = (u32x4){(unsigned)eid[4 * i], (unsigned)eid[4 * i + 1], (unsigned)eid[4 * i + 2], (unsigned)eid[4 * i + 3]};
                }
            }
        }
        __syncthreads();
    }
}

__device__ __forceinline__ unsigned xcc_id_now() { return (unsigned)__builtin_amdgcn_s_getreg((3 << 11) | 20) & 7u; }
__device__ __forceinline__ int q_next(unsigned* qcnt, int p, LAS int* slot) {
    __syncthreads();
    if (threadIdx.x == 0) *slot = (int)__hip_atomic_fetch_add(qcnt + 64 * p, 1u, __ATOMIC_RELAXED, __HIP_MEMORY_SCOPE_AGENT);
    __syncthreads();
    return *slot;
}
__device__ __forceinline__ int row16_sum_i(int x) {
    x += __builtin_amdgcn_update_dpp(0, x, 0xB1, 0xF, 0xF, true);
    x += __builtin_amdgcn_update_dpp(0, x, 0x4E, 0xF, 0xF, true);
    x += __builtin_amdgcn_update_dpp(0, x, 0x141, 0xF, 0xF, true);
    x += __builtin_amdgcn_update_dpp(0, x, 0x140, 0xF, 0xF, true);
    return x;
}
constexpr int P7B_SEGSTEP = 4;
__device__ __forceinline__ void p7b_udots(const Ctx& C, const Args& a) {
    unsigned char* ws = a.ws;
    const int lane = C.lane, wid = C.wave, sub = lane & 15, tg = lane >> 4;
    LAS unsigned char* wl = C.lds + 2048 + wid * 12800;
    LAS unsigned* lst = (LAS unsigned*)wl; LAS float* lgt = (LAS float*)(wl + 2048); LAS u32x4* xs = (LAS u32x4*)(wl + 4096); LAS float* sxs = (LAS float*)(wl + 12288);
    LAS int* lseg = (LAS int*)(wl + 12320);
    const float* SU = (const float*)(ws + WS_SCL); const float* SV = SU + PK * PK;
    const unsigned x0 = xcc_id_now();
    for (int gq = C.vcu * NWAVES + wid; gq < T / 4; gq += C.G * NWAVES) {
        const int t0w = gq * 4, t = t0w + tg;
        {
            const unsigned char* xr = ws + WS_X8 + (size_t)t * D + sub * 16;
#pragma unroll
            for (int j = 0; j < 8; ++j) xs[(tg * 8 + j) * 16 + sub] = *(const u32x4*)(xr + 256 * j);
            if (sub == 0) sxs[tg] = ((const float*)(ws + WS_SX))[t];
        }
        {
            const int* er = (const int*)(ws + WS_EXP) + (size_t)t * 128 + 8 * sub; const float* gr = (const float*)(ws + WS_GATE) + (size_t)t * 128 + 8 * sub;
            const u32x4 e0 = *(const u32x4*)er, e1 = *(const u32x4*)(er + 4); const f32x4 g0 = *(const f32x4*)gr, g1 = *(const f32x4*)(gr + 4);
            const unsigned ev[8] = {e0.x, e0.y, e0.z, e0.w, e1.x, e1.y, e1.z, e1.w}; const float gv[8] = {g0.x, g0.y, g0.z, g0.w, g1.x, g1.y, g1.z, g1.w};
            LAS int* hist = (LAS int*)(wl + 12416);
            hist[lane] = 0;
            asm volatile("s_waitcnt lgkmcnt(0)" ::: "memory");
            int key[8], rank[8];
#pragma unroll
            for (int i = 0; i < 8; ++i) { key[i] = (int)(((((ev[i] >> 10) - 2u * x0) & 15u) << 2) | ((ev[i] >> 8) & 3u));
                rank[i] = __hip_atomic_fetch_add(hist + key[i], 1, __ATOMIC_RELAXED, __HIP_MEMORY_SCOPE_WORKGROUP); }
            asm volatile("s_waitcnt lgkmcnt(0)" ::: "memory");
            const int cntl = hist[lane];
            int incl = cntl;
#pragma unroll
            for (int o = 1; o < 64; o <<= 1) { const int up = __shfl_up(incl, o); if (lane >= o) incl += up; }
            const int basel = incl - cntl;
            asm volatile("s_waitcnt lgkmcnt(0)" ::: "memory");
            hist[lane] = basel;
            if ((lane & 3) == 0) lseg[lane >> 2] = basel;
            if (lane == 0) lseg[16] = 512;
            asm volatile("s_waitcnt lgkmcnt(0)" ::: "memory");
#pragma unroll
            for (int i = 0; i < 8; ++i) { const int q = hist[key[i]] + rank[i]; lst[q] = ((unsigned)tg << 21) | ((unsigned)(8 * sub + i) << 14) | ev[i]; lgt[q] = gv[i]; }
        }
        asm volatile("s_waitcnt lgkmcnt(0)" ::: "memory");
#pragma unroll 1
        for (int r = 0; r < 16; r += P7B_SEGSTEP) {
            const int beg = __builtin_amdgcn_readfirstlane(lseg[r]), ntot = __builtin_amdgcn_readfirstlane(lseg[r + P7B_SEGSTEP]);
            unsigned en_n = (beg < ntot) ? lst[(beg + tg) < ntot ? beg + tg : ntot - 1] : 0u;
            for (int it = beg; it < ntot; it += 4) {
                const int i0 = it + tg;
                const unsigned en0 = en_n;
                { const int i1 = i0 + 4; en_n = lst[i1 < ntot ? i1 : ntot - 1]; }
                const int ea = (int)(en0 & 0x3FFFu), ta = (int)(en0 >> 21);
                const unsigned char* ua = ws + WS_UB + (size_t)ea * D + sub * 16;
                u32x4 ra[8];
#pragma unroll
                for (int j = 0; j < 8; ++j) ra[j] = *(const u32x4*)(ua + 256 * j);
                const float sua = SU[ea] * sxs[ta], sva = SV[ea];
                const float ga = lgt[i0 < ntot ? i0 : ntot - 1];
                int da = 0;
#pragma unroll
                for (int j = 0; j < 8; ++j) {
                    const u32x4 xa = xs[(ta * 8 + j) * 16 + sub];
                    da = __builtin_amdgcn_sdot4((int)ra[j].x, (int)xa.x, da, false); da = __builtin_amdgcn_sdot4((int)ra[j].y, (int)xa.y, da, false);
                    da = __builtin_amdgcn_sdot4((int)ra[j].z, (int)xa.z, da, false); da = __builtin_amdgcn_sdot4((int)ra[j].w, (int)xa.w, da, false);
                }
                da = row16_sum_i(da);
                const float ca = ga * gelu_tanh_f((float)da * sua) * sva;
                if (sub == 0 && i0 < ntot) ((float*)(ws + WS_CP))[(size_t)(t0w + ta) * 128 + ((en0 >> 14) & 127u)] = ca;
            }
        }
    }
}
constexpr int P7C_NCLS = 4, P7C_SHIFT = 12;
__device__ __forceinline__ void p7c_vacc(const Ctx& C, const Args& a) {
    unsigned char* ws = a.ws;
    const int lane = C.lane, wid = C.wave, sub = lane & 15, tg = lane >> 4;
    unsigned* qcnt = (unsigned*)(ws + WS_QCNT) + 64 * 8;
    LAS int* slot = (LAS int*)(C.lds + 1024);
    LAS int* lex = (LAS int*)(C.lds + 2048) + wid * 512 + tg * 128;
    LAS unsigned char* lcb = C.lds + 2048 + 16384 + wid * 512 + tg * 128;
    const unsigned x0 = xcc_id_now();
    for (int gq = C.vcu * NWAVES + wid; gq < T / 4; gq += C.G * NWAVES) {
        {
            const int t = gq * 4 + tg;
            const f32x4 c0 = *(const f32x4*)((const float*)(ws + WS_CP) + (size_t)t * 128 + 8 * sub), c1 = *(const f32x4*)((const float*)(ws + WS_CP) + (size_t)t * 128 + 8 * sub + 4);
            float mx = fmaxf(fmaxf(fmaxf(fabsf(c0.x), fabsf(c0.y)), fmaxf(fabsf(c0.z), fabsf(c0.w))), fmaxf(fmaxf(fabsf(c1.x), fabsf(c1.y)), fmaxf(fabsf(c1.z), fabsf(c1.w))));
#pragma unroll
            for (int o = 1; o < 16; o <<= 1) mx = fmaxf(mx, __shfl_xor(mx, o));
            const float inv = mx > 0.f ? 127.0f / mx : 0.f, sc8 = mx * (1.0f / 127.0f);
#define Q8C(v) ((int)rintf((v) * inv))
            const int q0 = Q8C(c0.x), q1 = Q8C(c0.y), q2 = Q8C(c0.z), q3 = Q8C(c0.w), q4 = Q8C(c1.x), q5 = Q8C(c1.y), q6 = Q8C(c1.z), q7 = Q8C(c1.w);
#undef Q8C
            int sq = (abs(q0) + abs(q1)) + (abs(q2) + abs(q3)) + (abs(q4) + abs(q5)) + (abs(q6) + abs(q7));
            sq = row16_sum_i(sq);
            const float bnd = ((const float*)(ws + WS_AMAX1))[t] + sc8 * (127.0f * (float)sq);
            const float invh = bnd > 0.f ? 127.0f / bnd : 0.f;
            if (sub == 0) ((float*)(ws + WS_SAH2))[t] = bnd * (1.0f / 127.0f);
            {
                const int* er = (const int*)(ws + WS_EXP) + (size_t)t * 128 + 8 * sub; const u32x4 e0 = *(const u32x4*)er, e1 = *(const u32x4*)(er + 4);
                const int qv[8] = {q0, q1, q2, q3, q4, q5, q6, q7};
                const unsigned ev[8] = {q0 ? e0.x : 0u, q1 ? e0.y : 0u, q2 ? e0.z : 0u, q3 ? e0.w : 0u, q4 ? e1.x : 0u, q5 ? e1.y : 0u, q6 ? e1.z : 0u, q7 ? e1.w : 0u};
                const unsigned below = (1u << sub) - 1u;
                int pos0 = 0;
#pragma unroll 1
                for (int cls = 0; cls < P7C_NCLS; ++cls) {
#pragma unroll
                    for (int i = 0; i < 8; ++i) {
                        const bool mt = (int)(ev[i] >> P7C_SHIFT) == cls;
                        const unsigned long long bm = __ballot(mt);
                        const unsigned gm = (unsigned)(bm >> (16 * tg)) & 0xFFFFu;
                        if (mt) { const int pos = pos0 + __builtin_popcount(gm & below); lex[pos] = (int)ev[i]; lcb[pos] = (unsigned char)(qv[i] & 0xff); }
                        pos0 += __builtin_popcount(gm);
                    }
                }
            }
            asm volatile("s_waitcnt lgkmcnt(0)" ::: "memory");
#pragma unroll 1
          for (int r = 0; r < 8; ++r) {
            const int p = (int)((x0 + (unsigned)r) & 7u);
            const unsigned char* vb = ws + WS_VB + (size_t)p * ((size_t)PK * PK * 256) + 16 * sub;
            int oacc[16];
#pragma unroll
            for (int i = 0; i < 16; ++i) oacc[i] = 0;
#pragma unroll 2
            for (int g4 = 0; g4 < 32; ++g4) {
                const u32x4 e4 = *(const LAS u32x4*)(lex + 4 * g4);
                const int cw = *(const LAS int*)(lcb + 4 * g4);
                const u32x4 r0 = *(const u32x4*)(vb + (size_t)e4.x * 256), r1 = *(const u32x4*)(vb + (size_t)e4.y * 256), r2 = *(const u32x4*)(vb + (size_t)e4.z * 256), r3 = *(const u32x4*)(vb + (size_t)e4.w * 256);
#define QUADW(W, idx) do { const unsigned ablo = __builtin_amdgcn_perm(r1.W, r0.W, 0x05010400u), abhi = __builtin_amdgcn_perm(r1.W, r0.W, 0x07030602u); \
                    const unsigned cdlo = __builtin_amdgcn_perm(r3.W, r2.W, 0x05010400u), cdhi = __builtin_amdgcn_perm(r3.W, r2.W, 0x07030602u); \
                    oacc[4 * (idx) + 0] = __builtin_amdgcn_sdot4((int)__builtin_amdgcn_perm(cdlo, ablo, 0x05040100u), cw, oacc[4 * (idx) + 0], false); \
                    oacc[4 * (idx) + 1] = __builtin_amdgcn_sdot4((int)__builtin_amdgcn_perm(cdlo, ablo, 0x07060302u), cw, oacc[4 * (idx) + 1], false); \
                    oacc[4 * (idx) + 2] = __builtin_amdgcn_sdot4((int)__builtin_amdgcn_perm(cdhi, abhi, 0x05040100u), cw, oacc[4 * (idx) + 2], false); \
                    oacc[4 * (idx) + 3] = __builtin_amdgcn_sdot4((int)__builtin_amdgcn_perm(cdhi, abhi, 0x07060302u), cw, oacc[4 * (idx) + 3], false); } while (0)
                QUADW(x, 0); QUADW(y, 1); QUADW(z, 2); QUADW(w, 3);
#undef QUADW
            }
            const size_t off = (size_t)t * D + 256 * p + 16 * sub;
            const bf16_t* h1r = (const bf16_t*)(ws + WS_H1B) + off; bf16_t* h2b = (bf16_t*)(ws + WS_XB) + off;
            const u32x4 hw0 = *(const u32x4*)h1r, hw1 = *(const u32x4*)(h1r + 8);
            const unsigned hw[8] = {hw0.x, hw0.y, hw0.z, hw0.w, hw1.x, hw1.y, hw1.z, hw1.w};
            float s3 = 0.f; unsigned ow[8]; unsigned qb[16];
#pragma unroll
            for (int q = 0; q < 8; ++q) {
                const float y0 = __builtin_bit_cast(float, hw[q] << 16) + sc8 * (float)oacc[2 * q], y1 = __builtin_bit_cast(float, hw[q] & 0xffff0000u) + sc8 * (float)oacc[2 * q + 1];
                s3 += y0 * y0 + y1 * y1; ow[q] = pk2(y0, y1);
                qb[2 * q] = (unsigned)(int)rintf(y0 * invh) & 0xffu; qb[2 * q + 1] = (unsigned)(int)rintf(y1 * invh) & 0xffu;
            }
            { u32x4 qv; qv.x = qb[0] | (qb[1] << 8) | (qb[2] << 16) | (qb[3] << 24); qv.y = qb[4] | (qb[5] << 8) | (qb[6] << 16) | (qb[7] << 24);
              qv.z = qb[8] | (qb[9] << 8) | (qb[10] << 16) | (qb[11] << 24); qv.w = qb[12] | (qb[13] << 8) | (qb[14] << 16) | (qb[15] << 24);
              *(u32x4*)(ws + WS_H2Q + off) = qv; }
            { u32x4 w0 = {ow[0], ow[1], ow[2], ow[3]}, w1 = {ow[4], ow[5], ow[6], ow[7]}; *(u32x4*)h2b = w0; *(u32x4*)(h2b + 8) = w1; }
#pragma unroll
            for (int o = 1; o < 16; o <<= 1) s3 += __shfl_xor(s3, o);
            if (sub == 0) ((float*)(ws + WS_SSQP))[(size_t)t * 8 + p] = s3;
          }
        }
    }
}
__device__ __noinline__ void grid_sync_all() { cg::this_grid().sync(); }
__device__ __forceinline__ bool phase_ctx(Ctx& C) { int t_ = threadIdx.x; asm volatile("" : "+v"(t_)); C.tid = t_; C.lane = t_ & 63; return true; }
template <int PH_MASK>
__global__ void __launch_bounds__(NTHR, 2) fwd(Args a) {
    extern __shared__ __attribute__((aligned(16))) unsigned char lds_raw[];
    Ctx C;
    C.tid = threadIdx.x; C.lane = C.tid & 63; C.wave = __builtin_amdgcn_readfirstlane(C.tid >> 6);
    C.G = gridDim.x; C.bid = blockIdx.x;
    C.vcu = (C.G % 8 == 0) ? (C.bid % 8) * (C.G / 8) + C.bid / 8 : C.bid;
    C.lds = (LAS unsigned char*)lds_raw;
    volatile LAS unsigned* bst = (volatile LAS unsigned*)(C.lds + LDS_BYTES - 64);
    if (C.tid < 2) bst[C.tid] = 0u;
    unsigned* barw = (unsigned*)(a.ws + WS_BAR);
    __syncthreads();
    const XcdBarrier xbar = xcd_barrier_post(barw, bst);
    if (a.ph_lo < 0) grid_sync_all();
#define IN(k) (((PH_MASK >> (k)) & 1) && a.ph_lo <= (k) && (k) < a.ph_hi && phase_ctx(C))
#define SEAM(k) do { if (IN(k) && IN((k) + 1)) xcd_barrier(xbar); } while (0)
    if (IN(0)) p0_prologue(C, a);
    SEAM(0);
    if (IN(1)) p1_inproj(C, a);
#ifdef SPLIT_INDEXER
    if (IN(2)) p2_scores(C, a);
    SEAM(2);
    if (IN(3)) p3_select(C, a);
    SEAM(3);
#else
    if (IN(2)) p23_index_select<((PH_MASK >> 1) & 1) != 0>(C, a);
    SEAM(2);
#endif
    if (IN(4)) p4_attention(C, a, (char*)lds_raw);
    SEAM(4);
    if (IN(5)) p5_outproj(C, a);
    SEAM(5);
    const bool rt_tile = (C.G == 256) && IN(6) && IN(7);
    if (IN(6)) {
        p5b_tokprep(C, a); xcd_barrier(xbar);
        p6_peerq_pp(C, a, false);
        if (rt_tile) {
            asm volatile("s_waitcnt vmcnt(0)" ::: "memory");
            const int w_ = (C.bid % 8) * 32 + C.bid / 8, in_ = w_ % 64;
            p7a_route(C, a, true, (w_ / 64) * 8 + in_ % 8, in_ / 8);
        }
        p6_peerq_pp(C, a, true);
    }
    if (!rt_tile) { SEAM(6); if (IN(7)) p7a_route(C, a, false, 0, 0); }
    SEAM(7);
    if (IN(8)) p7b_udots(C, a);
    SEAM(8);
    if (IN(9)) p7c_vacc(C, a);
    SEAM(9);
    if (IN(10)) p8_ple(C, a);
#undef IN
#undef SEAM
}

#ifndef REPEAT_PHASE
#define REPEAT_PHASE (-1)
#endif
template <int PH_MASK = 0x7FF>
inline void launch(void* const* d_in, void* d_out, void* d_ws, int lo, int hi, hipStream_t st) {
    static int grid = 0;
    if (!grid) {
        int dev = 0, cus = 0, per_cu = 0;
        hipGetDevice(&dev);
        hipDeviceGetAttribute(&cus, hipDeviceAttributeMultiprocessorCount, dev);
        hipFuncSetAttribute((const void*)fwd<PH_MASK>, hipFuncAttributeMaxDynamicSharedMemorySize, LDS_BYTES);
        hipOccupancyMaxActiveBlocksPerMultiprocessor(&per_cu, (const void*)fwd<PH_MASK>, NTHR, LDS_BYTES);
        if (per_cu < 1) fprintf(stderr, "fwd: occupancy query says %d blocks/CU\n", per_cu);
        grid = cus;
    }
    if (hipMemsetAsync((char*)d_ws + WS_BAR, 0, WS_CTL_BYTES, st) != hipSuccess) fprintf(stderr, "hipMemsetAsync of the control words failed\n");
    Args a{};
    for (int i = 0; i < 17; ++i) a.in[i] = (const float*)d_in[i];
    a.out = (float*)d_out; a.ws = (unsigned char*)d_ws; a.ph_lo = lo; a.ph_hi = hi; a.rep_phase = REPEAT_PHASE; a.pad = 0;
    void* args[] = {&a};
    hipError_t e = hipLaunchCooperativeKernel((const void*)fwd<PH_MASK>, dim3(grid), dim3(NTHR), args, LDS_BYTES, st);
    if (e != hipSuccess) fprintf(stderr, "cooperative launch failed: %s (grid %d)\n", hipGetErrorString(e), grid);
}
}
namespace fk {
__global__ __launch_bounds__(256) void k_adapt_proj(const unsigned char* ws, long delta, float* proj) {
    ws += delta;
    const int t = blockIdx.x;
    float* row = proj + (size_t)t * NPROJ;
    const size_t offs[7] = {WS_QA, WS_KA, WS_VA, WS_QB, WS_KB, WS_VBB, WS_QI};
    for (int i = threadIdx.x; i < 7168; i += 256) {
        const int seg = i >> 10, c = i & 1023;
        row[i] = bf2f(((const bf16_t*)(ws + offs[seg]))[(size_t)t * 1024 + c]);
    }
    if (threadIdx.x < 64) row[7168 + threadIdx.x] = bf2f(((const bf16_t*)(ws + WS_KI))[(size_t)t * 64 + threadIdx.x]);
    if (threadIdx.x < 16) row[7232 + threadIdx.x] = ((const float*)(ws + WS_WI))[(size_t)t * 16 + threadIdx.x] * 32.0f;
}
__global__ __launch_bounds__(256) void k_adapt_att(const bf16_t* o, float* att, size_t n) {
    for (size_t i = (size_t)blockIdx.x * 256 + threadIdx.x; i < n; i += (size_t)gridDim.x * 256) att[i] = bf2f(o[i]);
}
}
namespace fk {
__global__ __launch_bounds__(256) void k_adapt_qv(const bf16_t* qv, const float* h1, float* out) {
    __shared__ float red[4];
    const int t = blockIdx.x, tid = threadIdx.x;
    float s = 0.f;
    for (int i = tid; i < 2048; i += 256) { const float v = h1[(size_t)t * 2048 + i]; s += v * v; }
    s = wave_sum(s);
    if ((tid & 63) == 0) red[tid >> 6] = s;
    __syncthreads();
    const float rs2 = rsqrtf((red[0] + red[1] + red[2] + red[3]) * (1.0f / 2048.f) + 1e-6f);
    for (int i = tid; i < 2048; i += 256) out[(size_t)t * 2048 + i] = bf2f(qv[(size_t)t * 2048 + i]) * rs2;
}
}
extern "C" void kernel_launch(void* const* d_in, const int* in_sizes, int n_in, void* d_out, int out_size, void* d_ws, size_t ws_size, hipStream_t stream) {
    if (n_in != 17 || out_size != cfg::T * cfg::D || ws_size < fk::WS_END) {
        fprintf(stderr, "kernel_launch: unexpected shapes n_in=%d out=%d ws=%zu\n", n_in, out_size, ws_size);
        return;
    }
    fk::launch(d_in, d_out, d_ws, 0, 11, stream);
}
```
